# Optimizing an MI355X kernel written in HIP

```python
import jax, jax.numpy as jnp
from jax import lax
import numpy as np

D_MODEL = 1024
BATCH = 8
SEQ = 2048
DEPTH = 2
DEC_BATCH = 128
DEC_SEQ = 4
PAST_LEN = 16384
PAGE_SIZE = 128

D_MIX = D_MODEL
A_HEADS = 4
A_HEAD_DIM = D_MIX // 16
A_WIDTH = A_HEADS * A_HEAD_DIM
A_CHUNK = 128
B_HEADS = 8
B_KEY_DIM = D_MIX // 16
B_VAL_DIM = D_MIX // 16
B_KEY_WIDTH = B_HEADS * B_KEY_DIM
B_WIDTH = B_HEADS * B_VAL_DIM
B_CHUNK = 16
C_WIDTH = D_MIX // 4
C_CONV = 31
D_FF = 4 * D_MODEL
N_IN = 2 * A_WIDTH + 2 * B_KEY_WIDTH + 2 * B_WIDTH + 2 * C_WIDTH
EPS = 1e-6

kernel_name = "hybrid_gmlp_hgrn2_conformer_adaln_step"


def _rmsnorm(x, g):
    xf = x.astype(jnp.float32)
    y = xf * lax.rsqrt(jnp.mean(xf * xf, axis=-1, keepdims=True) + EPS)
    return (y * g.astype(jnp.float32)).astype(x.dtype)


def _layernorm(x, g, b):
    xf = x.astype(jnp.float32)
    xc = xf - jnp.mean(xf, axis=-1, keepdims=True)
    y = xc * lax.rsqrt(jnp.mean(xc * xc, axis=-1, keepdims=True) + EPS)
    return (y * g.astype(jnp.float32) + b.astype(jnp.float32)).astype(x.dtype)


def _chunk_gmlp(z, ln_g, ln_b, w_s, b_s):
    n, L, _ = z.shape
    z = jax.nn.gelu(z, approximate=False)
    u, v = jnp.split(z, 2, axis=-1)
    v = _layernorm(v, ln_g, ln_b)
    lc = min(L, A_CHUNK)
    nc = L // lc
    vh = v.reshape(n, nc, lc, A_HEADS, A_HEAD_DIM)
    mask = jnp.tril(jnp.ones((lc, lc), dtype=bool))
    w = jnp.where(mask, w_s[:, :lc, :lc], 0).astype(v.dtype)
    bias = b_s[:, :lc].T[None, None, :, :, None].astype(v.dtype)
    mixed = jnp.einsum('hts,ncshd->ncthd', w, vh) + bias
    return u * mixed.reshape(n, L, A_WIDTH), v


def _hgrn2(zq, zf, zi, zg, lb, gn_g, s0):
    f32 = jnp.float32
    n, L, _ = zq.shape
    q = (jax.nn.silu(zq.astype(f32)) * B_KEY_DIM ** -0.5).reshape(n, L, B_HEADS, B_KEY_DIM)
    f = lb.astype(f32) + (1.0 - lb.astype(f32)) * jax.nn.sigmoid(zf.astype(f32))
    logf = jnp.log(f).reshape(n, L, B_HEADS, B_KEY_DIM)
    k = (1.0 - f).reshape(n, L, B_HEADS, B_KEY_DIM)
    v = zi.astype(f32).reshape(n, L, B_HEADS, B_VAL_DIM)
    nchunk = -(-L // B_CHUNK)
    pad = nchunk * B_CHUNK - L

    def to_chunks(a):
        a = jnp.pad(a, ((0, 0), (0, pad), (0, 0), (0, 0)))
        return a.reshape(n, nchunk, B_CHUNK, B_HEADS, a.shape[-1]).transpose(1, 0, 3, 2, 4)

    mask = jnp.tril(jnp.ones((B_CHUNK, B_CHUNK), dtype=bool))

    def step(S, xs):
        qc, kc, vc, lfc = xs
        b = jnp.cumsum(lfc, axis=2)
        q_in = qc * jnp.exp(b)
        k_in = kc * jnp.exp(-b)
        scores = jnp.where(mask, jnp.einsum('nhtk,nhsk->nhts', q_in, k_in), 0.0)
        o = jnp.einsum('nhtk,nhkv->nhtv', q_in, S) + jnp.einsum('nhts,nhsv->nhtv', scores, vc)
        b_last = b[:, :, -1:, :]
        S = jnp.exp(b_last[:, :, 0, :, None]) * S + jnp.einsum('nhsk,nhsv->nhkv', kc * jnp.exp(b_last - b), vc)
        return S, o

    S, o = lax.scan(step, s0.astype(f32), (to_chunks(q), to_chunks(k), to_chunks(v), to_chunks(logf)))
    o = o.transpose(1, 0, 3, 2, 4).reshape(n, nchunk * B_CHUNK, B_HEADS, B_VAL_DIM)[:, :L]
    o = _rmsnorm(o, gn_g.reshape(B_HEADS, B_VAL_DIM)).reshape(n, L, B_WIDTH)
    o = o * jax.nn.silu(zg.astype(f32))
    return o.astype(zq.dtype), S


def _conformer_conv(z, buf, w_dw, b_dw, ln_g, ln_b):
    a, gate = jnp.split(z, 2, axis=-1)
    xg = a * jax.nn.sigmoid(gate)
    xx = jnp.concatenate([buf.astype(xg.dtype), xg], axis=1)
    y = lax.conv_general_dilated(
        xx, w_dw[:, None, :].astype(xg.dtype), window_strides=(1,), padding='VALID',
        dimension_numbers=('NWC', 'WIO', 'NWC'), feature_group_count=C_WIDTH)
    y = y + b_dw.astype(xg.dtype)
    y = jax.nn.silu(_layernorm(y, ln_g, ln_b))
    return y, xx[:, -(C_CONV - 1):]


def _trunk(x, c, s_hgrn, s_conv, lb_all, w_ada, b_ada, g_pre_mix, g_post_mix, g_pre_mlp, g_post_mlp,
           w_in, a_ln_g, a_ln_b, a_w_s, a_b_s, b_gn_g, c_w_dw, c_b_dw, c_ln_g, c_ln_b,
           w_out, w_up, w_down):
    sizes = [2 * A_WIDTH, B_KEY_WIDTH, B_KEY_WIDTH, B_WIDTH, B_WIDTH, 2 * C_WIDTH]
    split_at = [int(s) for s in np.cumsum(sizes)[:-1]]
    hg_out, cv_out, v_out = [], [], []
    for l in range(DEPTH):
        mod = jax.nn.silu(c) @ w_ada[l] + b_ada[l]
        sh1, sc1, gt1, sh2, sc2, gt2 = [m[:, None, :] for m in jnp.split(mod, 6, axis=-1)]
        h = _rmsnorm(x, g_pre_mix[l]) * (1.0 + sc1) + sh1
        z = h @ w_in[l]
        za, zq, zf, zi, zg, zc = jnp.split(z, split_at, axis=-1)
        ya, v_rows = _chunk_gmlp(za, a_ln_g[l], a_ln_b[l], a_w_s[l], a_b_s[l])
        yb, S = _hgrn2(zq, zf, zi, zg, lb_all[l], b_gn_g[l], s_hgrn[l])
        yc, buf = _conformer_conv(zc, s_conv[l], c_w_dw[l], c_b_dw[l], c_ln_g[l], c_ln_b[l])
        y = jnp.concatenate([ya, yb, yc], axis=-1) @ w_out[l]
        x = x + gt1 * _rmsnorm(y, g_post_mix[l])
        h = _rmsnorm(x, g_pre_mlp[l]) * (1.0 + sc2) + sh2
        y = jnp.square(jax.nn.relu(h @ w_up[l])) @ w_down[l]
        x = x + gt2 * _rmsnorm(y, g_post_mlp[l])
        hg_out.append(S.astype(s_hgrn.dtype))
        cv_out.append(buf.astype(s_conv.dtype))
        v_out.append(v_rows)
    return x, jnp.stack(hg_out), jnp.stack(cv_out), jnp.stack(v_out)


def setup_inputs(seed: int = 0) -> dict:
    key = jax.random.key(seed)
    ks = iter(jax.random.split(key, 32))
    nrm = lambda shape, s=1.0: jax.random.normal(next(ks), shape, jnp.float32) * s
    return {
        'x_prompt': nrm((BATCH, SEQ, D_MODEL)),
        'x_sample': nrm((DEC_BATCH, DEC_SEQ, D_MODEL)),
        'state_hgrn': nrm((DEPTH, DEC_BATCH, B_HEADS, B_KEY_DIM, B_VAL_DIM), 0.5),
        'state_conv': nrm((DEPTH, DEC_BATCH, C_CONV - 1, C_WIDTH), 0.5),
        'c_prompt': nrm((BATCH, D_MODEL)),
        'c_sample': nrm((DEC_BATCH, D_MODEL)),
        'w_ada': nrm((DEPTH, D_MODEL, 6 * D_MODEL), D_MODEL ** -0.5),
        'b_ada': nrm((DEPTH, 6 * D_MODEL), 0.01),
        'g_pre_mix': 1.0 + nrm((DEPTH, D_MODEL), 0.05),
        'g_post_mix': 1.0 + nrm((DEPTH, D_MODEL), 0.05),
        'g_pre_mlp': 1.0 + nrm((DEPTH, D_MODEL), 0.05),
        'g_post_mlp': 1.0 + nrm((DEPTH, D_MODEL), 0.05),
        'w_in': nrm((DEPTH, D_MODEL, N_IN), D_MODEL ** -0.5),
        'a_ln_g': 1.0 + nrm((DEPTH, A_WIDTH), 0.05),
        'a_ln_b': nrm((DEPTH, A_WIDTH), 0.02),
        'a_w_s': nrm((DEPTH, A_HEADS, A_CHUNK, A_CHUNK), A_CHUNK ** -0.5),
        'a_b_s': 1.0 + nrm((DEPTH, A_HEADS, A_CHUNK), 0.1),
        'b_lb': nrm((DEPTH, B_KEY_WIDTH), 1.0),
        'b_gn_g': 1.0 + nrm((DEPTH, B_WIDTH), 0.05),
        'c_w_dw': nrm((DEPTH, C_CONV, C_WIDTH), C_CONV ** -0.5),
        'c_b_dw': nrm((DEPTH, C_WIDTH), 0.02),
        'c_ln_g': 1.0 + nrm((DEPTH, C_WIDTH), 0.05),
        'c_ln_b': nrm((DEPTH, C_WIDTH), 0.02),
        'w_out': nrm((DEPTH, D_MIX, D_MODEL), D_MIX ** -0.5),
        'w_up': nrm((DEPTH, D_MODEL, D_FF), D_MODEL ** -0.5),
        'w_down': nrm((DEPTH, D_FF, D_MODEL), D_FF ** -0.5),
    }


def reference(x_prompt, x_sample, state_hgrn, state_conv, c_prompt, c_sample,
              w_ada, b_ada, g_pre_mix, g_post_mix, g_pre_mlp, g_post_mlp,
              w_in, a_ln_g, a_ln_b, a_w_s, a_b_s, b_lb, b_gn_g,
              c_w_dw, c_b_dw, c_ln_g, c_ln_b, w_out, w_up, w_down):
    lb_all = jnp.cumsum(jax.nn.softmax(b_lb.astype(jnp.float32), axis=0), axis=0)
    lb_all = lb_all - lb_all[0:1]
    weights = (w_ada, b_ada, g_pre_mix, g_post_mix, g_pre_mlp, g_post_mlp,
               w_in, a_ln_g, a_ln_b, a_w_s, a_b_s, b_gn_g, c_w_dw, c_b_dw, c_ln_g, c_ln_b,
               w_out, w_up, w_down)
    nb = x_prompt.shape[0]
    hg0 = jnp.zeros((DEPTH, nb, B_HEADS, B_KEY_DIM, B_VAL_DIM), x_prompt.dtype)
    cv0 = jnp.zeros((DEPTH, nb, C_CONV - 1, C_WIDTH), x_prompt.dtype)
    y_prompt, hgrn_prompt, conv_prompt, _ = _trunk(x_prompt, c_prompt, hg0, cv0, lb_all, *weights)
    y_sample, hgrn_sample, conv_sample, gmlp_v_sample = _trunk(
        x_sample, c_sample, state_hgrn, state_conv, lb_all, *weights)
    return (y_prompt, y_sample, hgrn_prompt, hgrn_sample, conv_prompt, conv_sample, gmlp_v_sample)
```

```cpp
#include <hip/hip_runtime.h>
#include <hip/hip_cooperative_groups.h>
#include <cstdio>
#include <cstdint>
namespace cg = cooperative_groups;
namespace pg8 {
#define PG8_LAS __attribute__((address_space(3)))
typedef unsigned short bf16_t;
typedef short bf16x8 __attribute__((ext_vector_type(8)));
typedef float f32x4 __attribute__((ext_vector_type(4)));
typedef unsigned u32x4 __attribute__((ext_vector_type(4)));
constexpr int BM = 256, BK = 64, HALF = 128, HTB = HALF * BK * 2  , STAGE_BYTES = 8 * HTB, NXCD = 8, WGM = 8;

__host__ __device__ __forceinline__ int lds_byte(int r, int c) { const int st = (r >> 4) * 2 + (c >> 5), rr = r & 15, cc = c & 31, ob = rr * 64 + cc * 2; return st * 1024 + (ob ^ (((ob >> 9) & 1) << 5)); }
__host__ __device__ __forceinline__ void stage_rc(int b, int& R, int& C) { const int st = b / 1024, sb = b % 1024, swz = sb ^ (((sb >> 9) & 1) << 5); R = (st >> 1) * 16 + swz / 64; C = (st & 1) * 32 + (swz % 64) / 2; }
__host__ __device__ __forceinline__ int perm32(int rho) { const int n = rho >> 4, i = rho & 15; return 8 * (i >> 2) + 4 * n + (i & 3); }

struct Unit { int pm, pn; };
struct Gemm { const bf16_t* A; const bf16_t* Bt; int M, N, K; };

struct StaticOrder {
    int nM, nN, nwg, G, c;
    __host__ __device__ void init(int M, int N, int G_, int c_) { nM = M / BM; nN = N / BM; nwg = nM * nN; G = G_; c = c_; }
    __host__ __device__ bool next(int i, Unit& u) const {
        const long L = (long)i * G + c; if (L >= nwg) return false;
        int wgid = (int)L; { const int q = nwg / NXCD, r = nwg % NXCD, xcd = wgid % NXCD, off = wgid / NXCD; wgid = (xcd < r ? xcd * (q + 1) : r * (q + 1) + (xcd - r) * q) + off; }
        const int nig = WGM * nN, gid = wgid / nig, fm = gid * WGM, gsz = (nM - fm) < WGM ? (nM - fm) : WGM;
        u.pm = fm + ((wgid % nig) % gsz); u.pn = (wgid % nig) / gsz; return true;
    }
    __device__ __forceinline__ void a_ready(const Unit&) const {}
    __device__ __forceinline__ void done(const Unit&) const {}
};

__device__ __forceinline__ unsigned cvt_pk_bf16(float lo, float hi) { unsigned r; asm volatile("v_cvt_pk_bf16_f32 %0, %1, %2" : "=v"(r) : "v"(lo), "v"(hi)); return r; }
typedef float f32x2 __attribute__((ext_vector_type(2)));
template <int MODE> struct EpiT {
    static constexpr bool PERM = true, AFTER_DRAIN = false;
    void* O; int ldc; const float* bias; int rowlim;
    __device__ __forceinline__ void operator()(const f32x4 (&acc)[2][2][4][2], const Unit& u, int wr, int wc, int fr, int fq) const {
        const int row0 = u.pm * BM + wr * 64 + fr; const int col0 = u.pn * BM + wc * 32 + 8 * fq;
#pragma unroll
        for (int ai = 0; ai < 2; ++ai)
#pragma unroll
            for (int m = 0; m < 4; ++m) { const int row = row0 + ai * HALF + m * 16;
#pragma unroll
                for (int bj = 0; bj < 2; ++bj) { f32x4 v0 = acc[ai][bj][m][0], v1 = acc[ai][bj][m][1]; const int col = col0 + bj * HALF;
                    if (MODE == 2) {
                        if (row < rowlim) { const f32x4 b0 = *(const f32x4*)(bias + col), b1 = *(const f32x4*)(bias + col + 4);
                            float* p = (float*)O + (size_t)row * ldc + col; *(f32x4*)p = v0 + b0; *(f32x4*)(p + 4) = v1 + b1; }
                    } else {
                        if (MODE == 1) {
#pragma unroll
                            for (int e = 0; e < 4; ++e) { float a = v0[e] > 0.f ? v0[e] : 0.f; v0[e] = a * a; float b = v1[e] > 0.f ? v1[e] : 0.f; v1[e] = b * b; } }
                        u32x4 w; w.x = cvt_pk_bf16(v0[0], v0[1]); w.y = cvt_pk_bf16(v0[2], v0[3]); w.z = cvt_pk_bf16(v1[0], v1[1]); w.w = cvt_pk_bf16(v1[2], v1[3]);
                        *(u32x4*)((bf16_t*)O + (size_t)row * ldc + col) = w; } } }
    }
};
template <class Epi, class Sched, bool ALIGN_EPI = false, bool SP2 = false>
__device__ __forceinline__ void gemm_phase(PG8_LAS unsigned char* lds, const Gemm g, const Sched& S, const Epi& E) {
    const int tid = threadIdx.x, wid = __builtin_amdgcn_readfirstlane(tid >> 6), lane = tid & 63, wr = wid >> 2, wc = wid & 3, fr = lane & 15, fq = lane >> 4;
    const int K = g.K, nt = K / BK;
    unsigned voffA[2], voffB[2];
#pragma unroll
    for (int i = 0; i < 2; ++i) { int R, C; stage_rc(tid * 16 + i * 8192, R, C); const int Rb = Epi::PERM ? ((R & ~31) + perm32(R & 31)) : R;
        voffA[i] = (unsigned)(R * K + C) * 2u; voffB[i] = (unsigned)(Rb * K + C) * 2u; }
    const size_t kstep = (size_t)(BK * 2);
    const size_t hstep = (size_t)HALF * K * 2;
    const size_t tstep = 2 * hstep;
    const unsigned ldsw = (unsigned)wid * 1024u;
    const int aoff = lds_byte(wr * 64 + fr, fq * 8), boff = lds_byte(wc * 32 + fr, fq * 8);
#define PG8_SA(b, h) (((b) * 2 + (h)) * HTB)
#define PG8_SB(b, h) ((4 + (b) * 2 + (h)) * HTB)
#define PG8_STAGE(bufoff, gbase, voff) do { _Pragma("unroll") for (int _i = 0; _i < 2; ++_i) \
        __builtin_amdgcn_global_load_lds((const unsigned*)((const char*)(gbase) + (voff)[_i]), (PG8_LAS unsigned*)(lds + (bufoff) + ldsw + _i * 8192), 16, 0, 0); } while (0)
#define PG8_LDA(dst, b, h) do { _Pragma("unroll") for (int m = 0; m < 4; ++m) _Pragma("unroll") for (int k = 0; k < 2; ++k) dst[m][k] = *(const PG8_LAS bf16x8*)(lds + PG8_SA(b, h) + aoff + m * 2048 + k * 1024); } while (0)
#define PG8_LDB(dst, b, h) do { _Pragma("unroll") for (int n = 0; n < 2; ++n) _Pragma("unroll") for (int k = 0; k < 2; ++k) dst[n][k] = *(const PG8_LAS bf16x8*)(lds + PG8_SB(b, h) + boff + n * 2048 + k * 1024); } while (0)
#define PG8_MMA(ai, bj, At, Bt) do { __builtin_amdgcn_s_setprio(1); _Pragma("unroll") for (int m = 0; m < 4; ++m) _Pragma("unroll") for (int n = 0; n < 2; ++n) _Pragma("unroll") for (int k = 0; k < 2; ++k) \
        acc[ai][bj][m][n] = __builtin_amdgcn_mfma_f32_16x16x32_bf16(Bt[n][k], At[m][k], acc[ai][bj][m][n], 0, 0, 0); __builtin_amdgcn_s_setprio(0); } while (0)
#define PG8_WAIT_V(n) asm volatile("s_waitcnt vmcnt(" #n ")" ::: "memory")
#define PG8_WAIT_L(n) asm volatile("s_waitcnt lgkmcnt(" #n ")" ::: "memory")
#define PG8_BAR __builtin_amdgcn_s_barrier()
#define PG8_SCHED __builtin_amdgcn_sched_barrier(0)
    Unit cur, nxt; int ui = 0;
    if (!S.next(0, cur)) return;
    f32x4 acc[2][2][4][2];
#pragma unroll
    for (int a = 0; a < 2; ++a)
#pragma unroll
        for (int b = 0; b < 2; ++b)
#pragma unroll
            for (int m = 0; m < 4; ++m)
#pragma unroll
                for (int n = 0; n < 2; ++n) acc[a][b][m][n] = (f32x4){0.f, 0.f, 0.f, 0.f};
    bf16x8 At[4][2], B0[2][2], B1[2][2];
    const char* cA = (const char*)g.A + (size_t)cur.pm * tstep; const char* cB = (const char*)g.Bt + (size_t)cur.pn * tstep;
    S.a_ready(cur);
    if constexpr (SP2) {
        PG8_STAGE(PG8_SB(0, 0), cB, voffB); PG8_STAGE(PG8_SB(0, 1), cB + hstep, voffB); PG8_STAGE(PG8_SA(0, 0), cA, voffA); PG8_STAGE(PG8_SA(0, 1), cA + hstep, voffA);
        if (wr == 1) PG8_BAR;
        PG8_WAIT_V(2); PG8_BAR;
        PG8_STAGE(PG8_SB(1, 0), cB + kstep, voffB); PG8_STAGE(PG8_SA(1, 0), cA + kstep, voffA); PG8_STAGE(PG8_SB(1, 1), cB + hstep + kstep, voffB);
        PG8_WAIT_V(6); PG8_BAR;
    } else {
        PG8_STAGE(PG8_SB(0, 0), cB, voffB); PG8_STAGE(PG8_SA(0, 0), cA, voffA); PG8_STAGE(PG8_SB(0, 1), cB + hstep, voffB); PG8_STAGE(PG8_SA(0, 1), cA + hstep, voffA);
        if (wr == 1) PG8_BAR;
        PG8_WAIT_V(4); PG8_BAR;
        PG8_STAGE(PG8_SB(1, 0), cB + kstep, voffB); PG8_STAGE(PG8_SA(1, 0), cA + kstep, voffA); PG8_STAGE(PG8_SB(1, 1), cB + hstep + kstep, voffB);
        PG8_WAIT_V(6); PG8_BAR;
    }
    for (;;) {
        const bool has_next = S.next(ui + 1, nxt);
        const char* nA = has_next ? (const char*)g.A + (size_t)nxt.pm * tstep : cA; const char* nB = has_next ? (const char*)g.Bt + (size_t)nxt.pn * tstep : cB;
        for (int t = 0; t < nt; t += 2) {
            const bool last = (t == nt - 2);
            const char* a1 = cA + (size_t)(t + 1) * kstep;
            const char* a2 = last ? nA : cA + (size_t)(t + 2) * kstep; const char* b2 = last ? nB : cB + (size_t)(t + 2) * kstep;
            const char* a3 = a2 + kstep; const char* b3 = b2 + kstep;
            if (last && has_next) S.a_ready(nxt);
            if constexpr (SP2) {
            PG8_LDB(B0, 0, 0); PG8_LDB(B1, 0, 1); PG8_SCHED; PG8_LDA(At, 0, 0); PG8_STAGE(PG8_SA(1, 1), a1 + hstep, voffA);
            PG8_WAIT_V(8); PG8_WAIT_L(0); PG8_BAR; PG8_MMA(0, 0, At, B0); PG8_MMA(0, 1, At, B1); PG8_BAR; PG8_SCHED;
            PG8_LDA(At, 0, 1); PG8_STAGE(PG8_SB(0, 0), b2, voffB); PG8_STAGE(PG8_SB(0, 1), b2 + hstep, voffB); PG8_STAGE(PG8_SA(0, 0), a2, voffA);
            PG8_WAIT_V(8); PG8_WAIT_L(0); PG8_BAR; PG8_MMA(1, 0, At, B0); PG8_MMA(1, 1, At, B1); PG8_BAR; PG8_SCHED;
            PG8_LDB(B0, 1, 0); PG8_LDB(B1, 1, 1); PG8_SCHED; PG8_LDA(At, 1, 0); PG8_STAGE(PG8_SA(0, 1), a2 + hstep, voffA);
            PG8_WAIT_V(8); PG8_WAIT_L(0); PG8_BAR; PG8_MMA(0, 0, At, B0); PG8_MMA(0, 1, At, B1); PG8_BAR; PG8_SCHED;
            PG8_LDA(At, 1, 1); PG8_STAGE(PG8_SB(1, 0), b3, voffB); PG8_STAGE(PG8_SB(1, 1), b3 + hstep, voffB); PG8_STAGE(PG8_SA(1, 0), a3, voffA);
            PG8_WAIT_V(8); PG8_WAIT_L(0); PG8_BAR; PG8_MMA(1, 0, At, B0); PG8_MMA(1, 1, At, B1); PG8_BAR; PG8_SCHED;
            } else {
            PG8_LDB(B0, 0, 0); PG8_SCHED; PG8_LDA(At, 0, 0); PG8_STAGE(PG8_SA(1, 1), a1 + hstep, voffA);
            PG8_WAIT_L(8); PG8_BAR; PG8_WAIT_L(0); PG8_MMA(0, 0, At, B0); PG8_BAR; PG8_SCHED;
            PG8_LDB(B1, 0, 1); PG8_STAGE(PG8_SB(0, 0), b2, voffB);
            PG8_BAR; PG8_WAIT_L(0); PG8_MMA(0, 1, At, B1); PG8_BAR;
            PG8_LDA(At, 0, 1); PG8_STAGE(PG8_SA(0, 0), a2, voffA);
            PG8_BAR; PG8_WAIT_L(0); PG8_MMA(1, 0, At, B0); PG8_BAR; PG8_SCHED;
            PG8_STAGE(PG8_SB(0, 1), b2 + hstep, voffB);
            PG8_WAIT_V(6); PG8_BAR; PG8_MMA(1, 1, At, B1); PG8_BAR;
            PG8_LDB(B0, 1, 0); PG8_SCHED; PG8_LDA(At, 1, 0); PG8_STAGE(PG8_SA(0, 1), a2 + hstep, voffA);
            PG8_WAIT_L(8); PG8_BAR; PG8_WAIT_L(0); PG8_MMA(0, 0, At, B0); PG8_BAR; PG8_SCHED;
            PG8_LDB(B1, 1, 1); PG8_STAGE(PG8_SB(1, 0), b3, voffB);
            PG8_BAR; PG8_WAIT_L(0); PG8_MMA(0, 1, At, B1); PG8_BAR;
            PG8_LDA(At, 1, 1); PG8_STAGE(PG8_SA(1, 0), a3, voffA);
            PG8_BAR; PG8_WAIT_L(0); PG8_MMA(1, 0, At, B0); PG8_BAR; PG8_SCHED;
            PG8_STAGE(PG8_SB(1, 1), b3 + hstep, voffB);
            PG8_WAIT_V(6); PG8_BAR; PG8_MMA(1, 1, At, B1); PG8_BAR;
            }
        }
        if constexpr (ALIGN_EPI) { if (wr == 0) PG8_BAR; }
        if constexpr (!Epi::AFTER_DRAIN) { E(acc, cur, wr, wc, fr, fq); S.done(cur); }
        if (!has_next) break;
#pragma unroll
        for (int a = 0; a < 2; ++a)
#pragma unroll
            for (int b = 0; b < 2; ++b)
#pragma unroll
                for (int m = 0; m < 4; ++m)
#pragma unroll
                    for (int n = 0; n < 2; ++n) acc[a][b][m][n] = (f32x4){0.f, 0.f, 0.f, 0.f};
        cur = nxt; cA = nA; cB = nB; ++ui;
        if constexpr (ALIGN_EPI) { if (wr == 1) PG8_BAR; }
    }
    PG8_WAIT_V(0);
    if constexpr (!ALIGN_EPI) { if (wr == 0) PG8_BAR; }
    PG8_BAR;
    if constexpr (Epi::AFTER_DRAIN) { E.fused(acc, cur, wr, wc, fr, fq, lds, wid, lane); S.done(cur); }
#undef PG8_SA
#undef PG8_SB
#undef PG8_STAGE
#undef PG8_LDA
#undef PG8_LDB
#undef PG8_MMA
#undef PG8_WAIT_V
#undef PG8_WAIT_L
#undef PG8_BAR
#undef PG8_SCHED
}
}

constexpr int DM = 1024, NB = 8, SEQ = 2048, NS = 128, DSEQ = 4, NIN = 3072, DFF = 4096;
constexpr int TP = NB * SEQ, TS = NS * DSEQ, T = TP + TS, NSEQ = NB + NS;
constexpr int Z_A = 0, Z_Q = 512, Z_F = 1024, Z_I = 1536, Z_G = 2048, Z_C = 2560;
constexpr int Y_A = 0, Y_B = 256, Y_C = 768;
constexpr int MODLD = 2 * 6 * DM;
constexpr float EPS = 1e-6f;
constexpr int HSEG = 128, NSEGS = SEQ / HSEG, HCH = HSEG / 16;
constexpr size_t O_Y = 0, O_HP = (size_t)T * DM, O_HS = O_HP + (size_t)2 * NB * 8 * 4096, O_CP = O_HS + (size_t)2 * NS * 8 * 4096,
                 O_CS = O_CP + (size_t)2 * NB * 30 * 256, O_GV = O_CS + (size_t)2 * NS * 30 * 256;
constexpr size_t MiB = 1u << 20;
constexpr size_t WS_AADA = 1 * MiB, WS_MOD = 2 * MiB, WS_WIN = 9 * MiB, WS_WOUT = 21 * MiB, WS_WUP = 25 * MiB, WS_WDN = 41 * MiB,
                 WS_HY = 57 * MiB, WS_Z = 90 * MiB, WS_YMIX = 189 * MiB, WS_U = 90 * MiB, WS_WADA = 90 * MiB, WS_SEGL = 222 * MiB, WS_SEGD = 238 * MiB, WS_END = 239 * MiB;
constexpr int LDS_BYTES = 147456, NWAVES = 8;

#define LAS __attribute__((address_space(3)))
typedef unsigned short bf16;
typedef float f32x4 __attribute__((ext_vector_type(4)));
typedef short s16x8 __attribute__((ext_vector_type(8)));
typedef short s16x4 __attribute__((ext_vector_type(4)));
typedef unsigned u32x2 __attribute__((ext_vector_type(2)));
typedef unsigned u32x4 __attribute__((ext_vector_type(4)));
#define LDS_FENCE() asm volatile("s_waitcnt lgkmcnt(0)" ::: "memory")

__device__ __forceinline__ float bf2f(unsigned b) { return __uint_as_float(b << 16); }
typedef float f32x2_t __attribute__((ext_vector_type(2))); typedef __bf16 bf16x2_t __attribute__((ext_vector_type(2)));
__device__ __forceinline__ unsigned pk2(float lo, float hi) { f32x2_t v = {lo, hi}; bf16x2_t b = __builtin_convertvector(v, bf16x2_t); return __builtin_bit_cast(unsigned, b); }
__device__ __forceinline__ unsigned f2bf(float f) { return pk2(f, 0.f) & 0xffffu; }
template <int CTRL> __device__ __forceinline__ float dpp_(float x) { return __builtin_bit_cast(float, __builtin_amdgcn_mov_dpp(__builtin_bit_cast(int, x), CTRL, 0xf, 0xf, true)); }
__device__ __forceinline__ float row16_sum(float v) {
    v += dpp_<0xB1>(v); v += dpp_<0x4E>(v); v += dpp_<0x141>(v); v += dpp_<0x128>(v); return v;
}
__device__ __forceinline__ float wave_sum(float v) {
    v = row16_sum(v);
    auto s = __builtin_amdgcn_permlane16_swap(__float_as_uint(v), __float_as_uint(v), false, false);
    v = __uint_as_float(s[0]) + __uint_as_float(s[1]);
    auto t = __builtin_amdgcn_permlane32_swap(__float_as_uint(v), __float_as_uint(v), false, false);
    return __uint_as_float(t[0]) + __uint_as_float(t[1]);
}
__device__ __forceinline__ float frcp(float x) { return __builtin_amdgcn_rcpf(x); }
__device__ __forceinline__ float sigmoidf_(float x) { return frcp(1.f + __expf(-x)); }
__device__ __forceinline__ float siluf_(float x) { return x * sigmoidf_(x); }
__device__ __forceinline__ float geluf_(float v) {
    const float t = frcp(fabsf(v) * 0.2316418882f + 1.0f);
    float q = t * 0.5307027145f + (-0.7265760135f); q = q * t + 0.7107068705f; q = q * t + (-0.142248368f); q = q * t + 0.127414796f; q = q * t;
    const float e = __builtin_amdgcn_exp2f(v * v * (-0.72134752044f));
    const float m = v * (q * e);
    return v < 0.f ? m : v - m;
}
__device__ __forceinline__ void unpack4(u32x2 r, float (&v)[4]) { v[0] = bf2f(r.x & 0xffffu); v[1] = bf2f(r.x >> 16); v[2] = bf2f(r.y & 0xffffu); v[3] = bf2f(r.y >> 16); }

struct Args { const float* in[26]; float* out; unsigned char* ws; };
enum { I_XP = 0, I_XS, I_SH, I_SC, I_CP, I_CS, I_WADA, I_BADA, I_GPRE1, I_GPOST1, I_GPRE2, I_GPOST2, I_WIN, I_ALNG, I_ALNB, I_AWS, I_ABS, I_BLB, I_BGN,
       I_CW, I_CB, I_CLNG, I_CLNB, I_WOUT, I_WUP, I_WDN };

__device__ __forceinline__ int seq_of_row(int r) { return r < TP ? (r >> 11) : NB + ((r - TP) >> 2); }

__device__ __forceinline__ void p0_transpose_item(const float* W, int K, int N, bf16* WT, int item, int lane) {
    const int nblk = N / 64, kb = item / nblk, nb = item % nblk, k0 = 64 * kb, n = 64 * nb + lane;
    const float* src = W + (size_t)k0 * N + n;
    float v[64];
#pragma unroll
    for (int i = 0; i < 64; ++i) v[i] = __builtin_nontemporal_load(src + (size_t)i * N);
    bf16* dst = WT + (size_t)n * K + k0;
#pragma unroll
    for (int g = 0; g < 8; ++g) { u32x4 o; o.x = pk2(v[8 * g], v[8 * g + 1]); o.y = pk2(v[8 * g + 2], v[8 * g + 3]); o.z = pk2(v[8 * g + 4], v[8 * g + 5]); o.w = pk2(v[8 * g + 6], v[8 * g + 7]);
        *(u32x4*)(dst + 8 * g) = o; }
}
constexpr int I_IN = 16 * 48, I_OUT = 16 * 16, I_UP = 16 * 64, I_DN = 64 * 16, I_ADA = 16 * 96;
constexpr int N_LATE0 = I_OUT + I_UP + I_DN, N_LATE1 = I_IN + I_OUT + I_UP + I_DN;
__device__ __forceinline__ void late_item(const Args& a, int lyr, int r, int lane) {
    unsigned char* ws = a.ws; const int l = lyr & 1;
    if (lyr == 2) { p0_transpose_item(a.in[I_WIN] + (size_t)DM * NIN, DM, NIN, (bf16*)(ws + WS_WIN) + (size_t)NIN * DM, r, lane); return; }
    if (r < I_OUT) { p0_transpose_item(a.in[I_WOUT] + (size_t)l * DM * DM, DM, DM, (bf16*)(ws + WS_WOUT) + (size_t)l * DM * DM, r, lane); return; } r -= I_OUT;
    if (r < I_UP) { p0_transpose_item(a.in[I_WUP] + (size_t)l * DM * DFF, DM, DFF, (bf16*)(ws + WS_WUP) + (size_t)l * DFF * DM, r, lane); return; } r -= I_UP;
    p0_transpose_item(a.in[I_WDN] + (size_t)l * DFF * DM, DFF, DM, (bf16*)(ws + WS_WDN) + (size_t)l * DM * DFF, r, lane);
}
__device__ __forceinline__ void p0_prologue(const Args& a, LAS unsigned char* lds, int gw, int NGW, int wave, int lane) {
    for (int it = gw; it < I_IN; it += NGW) p0_transpose_item(a.in[I_WIN], DM, NIN, (bf16*)(a.ws + WS_WIN), it, lane);
}

__device__ __forceinline__ const float* modp(const Args& a, int seq, int l, int part) { return (const float*)(a.ws + WS_MOD) + (size_t)seq * MODLD + (l * 6 + part) * DM; }
__device__ __forceinline__ void modulate_store(const f32x4 (&x)[4], const float* g, const float* sc, const float* sh, bf16* hrow, int lane) {
    float ss = 0.f;
#pragma unroll
    for (int j = 0; j < 4; ++j) ss += (x[j][0] * x[j][0] + x[j][1] * x[j][1]) + (x[j][2] * x[j][2] + x[j][3] * x[j][3]);
    const float rstd = rsqrtf(wave_sum(ss) * (1.f / DM) + EPS);
#pragma unroll
    for (int j = 0; j < 4; ++j) { const f32x4 gv = ((const f32x4*)g)[lane + 64 * j], sv = ((const f32x4*)sc)[lane + 64 * j], hv = ((const f32x4*)sh)[lane + 64 * j];
        const f32x4 h = x[j] * rstd * gv * (sv + 1.f) + hv; u32x2 w; w.x = pk2(h[0], h[1]); w.y = pk2(h[2], h[3]); ((u32x2*)hrow)[lane + 64 * j] = w; }
}
template <int MODE>
__device__ __forceinline__ void norm_rows(const float* xin, float* xout, bf16* hy, int nrows, const float* gate, const float* gpost, const float* gnext, const float* sc, const float* sh, int lane) {
    f32x4 cA[4], cB[4], cC[4];
#pragma unroll
    for (int j = 0; j < 4; ++j) {
        if (MODE != 0) cA[j] = ((const f32x4*)gate)[lane + 64 * j] * ((const f32x4*)gpost)[lane + 64 * j];
        if (MODE != 2) { cB[j] = ((const f32x4*)gnext)[lane + 64 * j] * (((const f32x4*)sc)[lane + 64 * j] + 1.f); cC[j] = ((const f32x4*)sh)[lane + 64 * j]; } }
    f32x4 x[4]; u32x2 yr[4];
#pragma unroll
    for (int j = 0; j < 4; ++j) { x[j] = __builtin_nontemporal_load((const f32x4*)xin + lane + 64 * j); if (MODE != 0) yr[j] = __builtin_nontemporal_load((const u32x2*)hy + lane + 64 * j); }
    for (int i = 0; i < nrows; ++i) {
        f32x4 nx[4]; u32x2 nyr[4];
        if (i + 1 < nrows) {
#pragma unroll
            for (int j = 0; j < 4; ++j) { nx[j] = __builtin_nontemporal_load((const f32x4*)(xin + (size_t)(i + 1) * DM) + lane + 64 * j); if (MODE != 0) nyr[j] = __builtin_nontemporal_load((const u32x2*)(hy + (size_t)(i + 1) * DM) + lane + 64 * j); } }
        if (MODE != 0) {
            f32x4 y[4]; float ss = 0.f;
#pragma unroll
            for (int j = 0; j < 4; ++j) { float t[4]; unpack4(yr[j], t); y[j] = (f32x4){t[0], t[1], t[2], t[3]}; ss += (t[0] * t[0] + t[1] * t[1]) + (t[2] * t[2] + t[3] * t[3]); }
            const float rstd = rsqrtf(wave_sum(ss) * (1.f / DM) + EPS);
#pragma unroll
            for (int j = 0; j < 4; ++j) { x[j] = x[j] + cA[j] * (y[j] * rstd); __builtin_nontemporal_store(x[j], (f32x4*)(xout + (size_t)i * DM) + lane + 64 * j); }
        }
        if (MODE != 2) {
            float ss = 0.f;
#pragma unroll
            for (int j = 0; j < 4; ++j) ss += (x[j][0] * x[j][0] + x[j][1] * x[j][1]) + (x[j][2] * x[j][2] + x[j][3] * x[j][3]);
            const float rstd = rsqrtf(wave_sum(ss) * (1.f / DM) + EPS);
#pragma unroll
            for (int j = 0; j < 4; ++j) { const f32x4 h = x[j] * rstd * cB[j] + cC[j]; u32x2 w; w.x = pk2(h[0], h[1]); w.y = pk2(h[2], h[3]); ((u32x2*)(hy + (size_t)i * DM))[lane + 64 * j] = w; }
        }
        if (i + 1 < nrows) {
#pragma unroll
            for (int j = 0; j < 4; ++j) { x[j] = nx[j]; if (MODE != 0) yr[j] = nyr[j]; } }
    }
}
__device__ __forceinline__ void prenorm0_phase(const Args& a, int gw, int NGW, int lane) {
    bf16* HY = (bf16*)(a.ws + WS_HY);
    for (int r0 = gw * 8; r0 < TP; r0 += NGW * 8) { const int s = r0 >> 11;
        norm_rows<0>(a.in[I_XP] + (size_t)r0 * DM, nullptr, HY + (size_t)r0 * DM, 8, nullptr, nullptr, a.in[I_GPRE1], modp(a, s, 0, 1), modp(a, s, 0, 0), lane); }
    for (int q = NGW - 1 - gw; q < TS; q += NGW) { const int s = NB + (q >> 2);
        norm_rows<0>(a.in[I_XS] + (size_t)q * DM, nullptr, HY + (size_t)(TP + q) * DM, 1, nullptr, nullptr, a.in[I_GPRE1], modp(a, s, 0, 1), modp(a, s, 0, 0), lane); }
}
template <int L, int WHICH>
__device__ __forceinline__ void postnorm_phase(const Args& a, int gw, int NGW, int lane) {
    constexpr int l = L, which = WHICH;
    bf16* HY = (bf16*)(a.ws + WS_HY);
    const float* gpost = a.in[which == 0 ? I_GPOST1 : I_GPOST2] + (size_t)l * DM;
    constexpr bool from_input = (l == 0 && which == 0);
    constexpr bool has_next = (which == 0) || (l + 1 < 2);
    constexpr int nl = which == 0 ? l : (l + 1 < 2 ? l + 1 : l);
    constexpr int MODE = has_next ? 1 : 2;
    const float* gnext = a.in[which == 0 ? I_GPRE2 : I_GPRE1] + (size_t)nl * DM;
    for (int r0 = gw * 8; r0 < TP; r0 += NGW * 8) { const int s = r0 >> 11;
        const float* xin = from_input ? a.in[I_XP] + (size_t)r0 * DM : a.out + (size_t)r0 * DM;
        norm_rows<MODE>(xin, a.out + (size_t)r0 * DM, HY + (size_t)r0 * DM, 8, modp(a, s, l, which == 0 ? 2 : 5), gpost, gnext, modp(a, s, nl, which == 0 ? 4 : 1), modp(a, s, nl, which == 0 ? 3 : 0), lane); }
    for (int q = NGW - 1 - gw; q < TS; q += NGW) { const int s = NB + (q >> 2); const int r = TP + q;
        const float* xin = from_input ? a.in[I_XS] + (size_t)q * DM : a.out + (size_t)r * DM;
        norm_rows<MODE>(xin, a.out + (size_t)r * DM, HY + (size_t)r * DM, 1, modp(a, s, l, which == 0 ? 2 : 5), gpost, gnext, modp(a, s, nl, which == 0 ? 4 : 1), modp(a, s, nl, which == 0 ? 3 : 0), lane); }
}

constexpr int VT_LD = 136;
template <int HALF> __device__ __forceinline__ void gmlp_chunk(const Args& a, int l, int chunk, LAS unsigned char* lds, int wave, int lane) {
    constexpr int NR = HALF ? 16 : 12, TT0 = HALF ? 6 : 0, TT1 = HALF ? 8 : 6;
    const bf16* Z = (const bf16*)(a.ws + WS_Z); bf16* Y = (bf16*)(a.ws + WS_YMIX);
    LAS bf16* vT = (LAS bf16*)lds;
    const int r0 = chunk * 128, fr = lane & 15, fq = lane >> 4;
    const f32x4 lg = ((const f32x4*)(a.in[I_ALNG] + l * 256))[lane], lb = ((const f32x4*)(a.in[I_ALNB] + l * 256))[lane];
    u32x2 rawv[NR];
#pragma unroll
    for (int i = 0; i < NR; ++i) rawv[i] = __builtin_nontemporal_load((const u32x2*)(Z + (size_t)(r0 + wave + 8 * i) * NIN + Z_A + 256 + 4 * lane));
#pragma unroll 4
    for (int i = 0; i < NR; ++i) { const int s = wave + 8 * i;
        float g[4]; unpack4(rawv[i], g);
#pragma unroll
        for (int e = 0; e < 4; ++e) g[e] = geluf_(g[e]);
        const float mean = wave_sum((g[0] + g[1]) + (g[2] + g[3])) * (1.f / 256.f);
#pragma unroll
        for (int e = 0; e < 4; ++e) g[e] -= mean;
        const float rstd = rsqrtf(wave_sum((g[0] * g[0] + g[1] * g[1]) + (g[2] * g[2] + g[3] * g[3])) * (1.f / 256.f) + EPS);
#pragma unroll
        for (int e = 0; e < 4; ++e) vT[(4 * lane + e) * VT_LD + s] = (bf16)f2bf(g[e] * rstd * lg[e] + lb[e]);
    }
    __syncthreads();
    const int h = wave >> 1, dtp = wave & 1;
    const float* W = a.in[I_AWS] + ((size_t)l * 4 + h) * 128 * 128; const float* bs = a.in[I_ABS] + (l * 4 + h) * 128;
#pragma unroll
    for (int tt = TT0; tt < TT1; ++tt) {
        f32x4 acc0 = {0.f, 0.f, 0.f, 0.f}, acc1 = {0.f, 0.f, 0.f, 0.f};
        const int t = 16 * tt + fr;
        constexpr int NK = 4;
        f32x4 w0[NK], w1[NK];
#pragma unroll
        for (int ks = 0; ks < NK; ++ks) if (ks <= (tt >> 1)) { const int s0 = 32 * ks + 8 * fq; w0[ks] = *(const f32x4*)(W + t * 128 + s0); w1[ks] = *(const f32x4*)(W + t * 128 + s0 + 4); }
        const float bias = bs[t];
        u32x2 rawu[2];
#pragma unroll
        for (int i = 0; i < 2; ++i) rawu[i] = __builtin_nontemporal_load((const u32x2*)(Z + (size_t)(r0 + t) * NIN + Z_A + h * 64 + (2 * dtp + i) * 16 + 4 * fq));
#pragma unroll
        for (int ks = 0; ks < NK; ++ks) if (ks <= (tt >> 1)) {
            const int s0 = 32 * ks + 8 * fq;
#pragma unroll
            for (int e = 0; e < 4; ++e) { if (s0 + e > t) w0[ks][e] = 0.f; if (s0 + 4 + e > t) w1[ks][e] = 0.f; }
            u32x4 bw; bw.x = pk2(w0[ks][0], w0[ks][1]); bw.y = pk2(w0[ks][2], w0[ks][3]); bw.z = pk2(w1[ks][0], w1[ks][1]); bw.w = pk2(w1[ks][2], w1[ks][3]);
            const s16x8 B = __builtin_bit_cast(s16x8, bw);
            const s16x8 A0 = *(const LAS s16x8*)(vT + (h * 64 + (2 * dtp) * 16 + fr) * VT_LD + s0);
            const s16x8 A1 = *(const LAS s16x8*)(vT + (h * 64 + (2 * dtp + 1) * 16 + fr) * VT_LD + s0);
            acc0 = __builtin_amdgcn_mfma_f32_16x16x32_bf16(A0, B, acc0, 0, 0, 0);
            acc1 = __builtin_amdgcn_mfma_f32_16x16x32_bf16(A1, B, acc1, 0, 0, 0);
        }
#pragma unroll
        for (int i = 0; i < 2; ++i) { const int col = h * 64 + (2 * dtp + i) * 16 + 4 * fq; const f32x4 m = i == 0 ? acc0 : acc1;
            float u[4]; unpack4(rawu[i], u);
            float o[4];
#pragma unroll
            for (int e = 0; e < 4; ++e) o[e] = geluf_(u[e]) * (m[e] + bias);
            u32x2 w; w.x = pk2(o[0], o[1]); w.y = pk2(o[2], o[3]); *(u32x2*)(Y + (size_t)(r0 + t) * DM + Y_A + col) = w; }
    }
    __syncthreads();
}
__device__ __forceinline__ void gmlp_sample(const Args& a, int l, int n, int lane) {
    const bf16* Z = (const bf16*)(a.ws + WS_Z); bf16* Y = (bf16*)(a.ws + WS_YMIX);
    const f32x4 lg = ((const f32x4*)(a.in[I_ALNG] + l * 256))[lane], lb = ((const f32x4*)(a.in[I_ALNB] + l * 256))[lane];
    const int h = lane >> 4; const float* W = a.in[I_AWS] + ((size_t)l * 4 + h) * 128 * 128; const float* bs = a.in[I_ABS] + (l * 4 + h) * 128;
    float v[4][4];
#pragma unroll
    for (int t = 0; t < 4; ++t) { const int r = TP + 4 * n + t;
        const u32x2 raw = *(const u32x2*)(Z + (size_t)r * NIN + Z_A + 256 + 4 * lane); float g[4]; unpack4(raw, g);
#pragma unroll
        for (int i = 0; i < 4; ++i) g[i] = geluf_(g[i]);
        const float mean = wave_sum((g[0] + g[1]) + (g[2] + g[3])) * (1.f / 256.f);
#pragma unroll
        for (int i = 0; i < 4; ++i) g[i] -= mean;
        const float rstd = rsqrtf(wave_sum((g[0] * g[0] + g[1] * g[1]) + (g[2] * g[2] + g[3] * g[3])) * (1.f / 256.f) + EPS);
#pragma unroll
        for (int i = 0; i < 4; ++i) v[t][i] = g[i] * rstd * lg[i] + lb[i];
        *(f32x4*)(a.out + O_GV + ((size_t)(l * NS + n) * 4 + t) * 256 + 4 * lane) = (f32x4){v[t][0], v[t][1], v[t][2], v[t][3]};
    }
#pragma unroll
    for (int t = 0; t < 4; ++t) { const int r = TP + 4 * n + t; const float bias = bs[t];
        const u32x2 raw = *(const u32x2*)(Z + (size_t)r * NIN + Z_A + 4 * lane); float u[4]; unpack4(raw, u); float o[4];
#pragma unroll
        for (int i = 0; i < 4; ++i) { float m = bias;
#pragma unroll
            for (int s = 0; s <= t; ++s) m += W[t * 128 + s] * v[s][i];
            o[i] = geluf_(u[i]) * m; }
        u32x2 w; w.x = pk2(o[0], o[1]); w.y = pk2(o[2], o[3]); *(u32x2*)(Y + (size_t)r * DM + Y_A + 4 * lane) = w; }
}

__device__ __forceinline__ void conv_item(const Args& a, int l, int seq, int t0, int nt, LAS unsigned char* lds, int tid, int wave, int lane) {
    const bf16* Z = (const bf16*)(a.ws + WS_Z); bf16* Y = (bf16*)(a.ws + WS_YMIX);
    LAS float* xs = (LAS float*)lds;
    const bool samp = seq >= NB; const int n = seq - NB; const int rowbase = samp ? TP + 4 * n : seq * SEQ;
    if (!samp) {
        u32x2 ra[12], rg[12];
#pragma unroll
        for (int i = 0; i < 12; ++i) { const int p = wave + 8 * i; int t = t0 - 30 + p; t = t < 0 ? 0 : t; const int pp = p < 94 ? t : t0;
            const bf16* zr = Z + (size_t)(rowbase + pp) * NIN + Z_C + 4 * lane; ra[i] = __builtin_nontemporal_load((const u32x2*)zr); rg[i] = __builtin_nontemporal_load((const u32x2*)(zr + 256)); }
#pragma unroll
        for (int i = 0; i < 12; ++i) { const int p = wave + 8 * i; const int t = t0 - 30 + p;
            if (p < 94) { float av[4], gv[4]; unpack4(ra[i], av); unpack4(rg[i], gv); f32x4 xg;
#pragma unroll
                for (int e = 0; e < 4; ++e) xg[e] = t >= 0 ? av[e] * sigmoidf_(gv[e]) : 0.f;
                *(LAS f32x4*)(xs + p * 256 + 4 * lane) = xg;
                if (t >= SEQ - 30) __builtin_nontemporal_store(xg, (f32x4*)(a.out + O_CP + ((size_t)(l * NB + seq) * 30 + (t - (SEQ - 30))) * 256 + 4 * lane)); } }
    } else {
        for (int p = wave; p < nt + 30; p += 8) {
            const int t = t0 - 30 + p; f32x4 xg = {0.f, 0.f, 0.f, 0.f};
            if (t >= 0) { const bf16* zr = Z + (size_t)(rowbase + t) * NIN + Z_C + 4 * lane; float av[4], gv[4]; unpack4(*(const u32x2*)zr, av); unpack4(*(const u32x2*)(zr + 256), gv);
#pragma unroll
                for (int e = 0; e < 4; ++e) xg[e] = av[e] * sigmoidf_(gv[e]); }
            else xg = *(const f32x4*)(a.in[I_SC] + ((size_t)(l * NS + n) * 30 + (30 + t)) * 256 + 4 * lane);
            *(LAS f32x4*)(xs + p * 256 + 4 * lane) = xg;
            if (p >= 4) __builtin_nontemporal_store(xg, (f32x4*)(a.out + O_CS + ((size_t)(l * NS + n) * 30 + (p - 4)) * 256 + 4 * lane));
        }
    }
    __syncthreads();
    const int c = tid & 255, tb = 32 * (tid >> 8);
    float y[32];
    if (tb < nt) {
        float w[31]; const float* wd = a.in[I_CW] + (size_t)l * 31 * 256 + c;
#pragma unroll
        for (int j = 0; j < 31; ++j) w[j] = wd[j * 256];
        const float bias = a.in[I_CB][l * 256 + c];
#pragma unroll
        for (int i = 0; i < 32; ++i) y[i] = bias;
#pragma unroll
        for (int p = 0; p < 62; ++p) { const float x = xs[(tb + p) * 256 + c];
#pragma unroll
            for (int i = (p > 30 ? p - 30 : 0); i <= (p < 31 ? p : 31); ++i) y[i] += w[p - i] * x; }
    }
    __syncthreads();
    if (tb < nt) {
#pragma unroll
        for (int i = 0; i < 32; ++i) xs[(tb + i) * 256 + c] = y[i];
    }
    __syncthreads();
    const f32x4 lg = ((const f32x4*)(a.in[I_CLNG] + l * 256))[lane], lb = ((const f32x4*)(a.in[I_CLNB] + l * 256))[lane];
    for (int tk = wave; tk < nt; tk += 8) {
        f32x4 v = *(const LAS f32x4*)(xs + tk * 256 + 4 * lane);
        const float mean = wave_sum((v[0] + v[1]) + (v[2] + v[3])) * (1.f / 256.f);
        v = v - mean;
        const float rstd = rsqrtf(wave_sum((v[0] * v[0] + v[1] * v[1]) + (v[2] * v[2] + v[3] * v[3])) * (1.f / 256.f) + EPS);
        float o[4];
#pragma unroll
        for (int e = 0; e < 4; ++e) o[e] = siluf_(v[e] * rstd * lg[e] + lb[e]);
        u32x2 w; w.x = pk2(o[0], o[1]); w.y = pk2(o[2], o[3]); *(u32x2*)(Y + (size_t)(rowbase + t0 + tk) * DM + Y_C + 4 * lane) = w;
    }
    __syncthreads();
}

template <bool WITH_O>
__device__ __forceinline__ void hgrn_run(const bf16* Z, bf16* Y, int row0, int nchunk, int ntok, int h, float lbk, const float* gn, f32x4 (&S)[4][4], float& btot, LAS unsigned char* wl, int lane) {
    LAS bf16* Q = (LAS bf16*)wl; LAS bf16* Kt = (LAS bf16*)(wl + 2048); LAS bf16* KT = (LAS bf16*)(wl + 4096); LAS float* Dv = (LAS float*)(wl + 6144);
    const float omlb = 1.f - lbk;
    const bf16* zb = Z + (size_t)row0 * NIN + h * 64;
    bf16* yb = WITH_O ? Y + (size_t)row0 * DM + Y_B + h * 64 : nullptr;
    for (int c = 0; c < nchunk; ++c, zb += 16 * NIN, yb += 16 * DM) {
        unsigned la = (unsigned)lane; asm volatile("" : "+v"(la));
        const unsigned fr = la & 15u, fq = la >> 4;
        const int nv = ntok - c * 16;
        float b = 0.f; unsigned kpk[8];
#pragma unroll
        for (int t = 0; t < 16; ++t) {
            float q = 0.f, kk = 0.f, lf = 0.f;
            if (t < nv) { const bf16* zr = zb + t * NIN;
                const float zq = bf2f(zr[la + Z_Q]), zf = bf2f(zr[la + Z_F]);
                const float e = __expf(-zf), sg = frcp(1.f + e);
                const float f = lbk + omlb * sg; lf = __logf(f); kk = omlb * (e * sg); q = siluf_(zq) * 0.125f; }
            b += lf; const float eb = __expf(b); const float qin = q * eb, kin = kk * frcp(eb);
            const unsigned kb = f2bf(kin);
            if (WITH_O) { Q[t * 64 + la] = (bf16)f2bf(qin); Kt[t * 64 + la] = (bf16)kb; }
            if (t & 1) kpk[t >> 1] |= kb << 16; else kpk[t >> 1] = kb;
        }
        *(LAS u32x4*)(KT + la * 16) = (u32x4){kpk[0], kpk[1], kpk[2], kpk[3]}; *(LAS u32x4*)(KT + la * 16 + 8) = (u32x4){kpk[4], kpk[5], kpk[6], kpk[7]};
        Dv[la] = __expf(b); btot += b;
        LDS_FENCE();
        s16x4 vB[4];
#pragma unroll
        for (int vt = 0; vt < 4; ++vt) { unsigned e[4];
#pragma unroll
            for (int j = 0; j < 4; ++j) { const unsigned tok = 4 * fq + j; e[j] = (int)tok < nv ? (unsigned)zb[tok * NIN + Z_I + 16 * vt + fr] : 0u; }
            vB[vt] = __builtin_bit_cast(s16x4, (u32x2){e[0] | (e[1] << 16), e[2] | (e[3] << 16)}); }
        f32x4 Dk[4];
#pragma unroll
        for (int kt = 0; kt < 4; ++kt) Dk[kt] = *(const LAS f32x4*)(Dv + 16 * kt + 4 * fq);
        f32x4 o[4];
        if (WITH_O) {
            s16x4 qa[4], ka[4];
#pragma unroll
            for (int kt = 0; kt < 4; ++kt) { qa[kt] = *(const LAS s16x4*)(Q + fr * 64 + 16 * kt + 4 * fq); ka[kt] = *(const LAS s16x4*)(Kt + fr * 64 + 16 * kt + 4 * fq); }
            f32x4 sT = {0.f, 0.f, 0.f, 0.f};
#pragma unroll
            for (int kt = 0; kt < 4; ++kt) sT = __builtin_amdgcn_mfma_f32_16x16x16bf16_1k(ka[kt], qa[kt], sT, 0, 0, 0);
#pragma unroll
            for (int j = 0; j < 4; ++j) if (4 * fq + j > fr) sT[j] = 0.f;
            const s16x4 P = __builtin_bit_cast(s16x4, (u32x2){pk2(sT[0], sT[1]), pk2(sT[2], sT[3])});
#pragma unroll
            for (int vt = 0; vt < 4; ++vt) { f32x4 acc = {0.f, 0.f, 0.f, 0.f};
                acc = __builtin_amdgcn_mfma_f32_16x16x16bf16_1k(P, vB[vt], acc, 0, 0, 0);
#pragma unroll
                for (int kt = 0; kt < 4; ++kt) { const s16x4 Sb = __builtin_bit_cast(s16x4, (u32x2){pk2(S[kt][vt][0], S[kt][vt][1]), pk2(S[kt][vt][2], S[kt][vt][3])});
                    acc = __builtin_amdgcn_mfma_f32_16x16x16bf16_1k(qa[kt], Sb, acc, 0, 0, 0); }
                o[vt] = acc; }
        }
#pragma unroll
        for (int kt = 0; kt < 4; ++kt) { const s16x4 KTa = *(const LAS s16x4*)(KT + (16 * kt + fr) * 16 + 4 * fq);
#pragma unroll
            for (int vt = 0; vt < 4; ++vt) { S[kt][vt] = __builtin_amdgcn_mfma_f32_16x16x16bf16_1k(KTa, vB[vt], S[kt][vt], 0, 0, 0); S[kt][vt] = S[kt][vt] * Dk[kt]; } }
        if (WITH_O) {
            float gnv[4];
#pragma unroll
            for (int vt = 0; vt < 4; ++vt) gnv[vt] = gn[16 * vt + fr];
#pragma unroll
            for (int j = 0; j < 4; ++j) { float ss = (o[0][j] * o[0][j] + o[1][j] * o[1][j]) + (o[2][j] * o[2][j] + o[3][j] * o[3][j]);
                ss = row16_sum(ss);
                const float rstd = rsqrtf(ss * (1.f / 64.f) + EPS);
                const unsigned tok = 4 * fq + j;
                if ((int)tok < nv) {
#pragma unroll
                    for (int vt = 0; vt < 4; ++vt) { const float zg = bf2f(zb[tok * NIN + Z_G + 16 * vt + fr]);
                        yb[tok * DM + 16 * vt + fr] = (bf16)f2bf(o[vt][j] * rstd * gnv[vt] * siluf_(zg)); } } }
        }
        LDS_FENCE();
    }
}
template <bool WITH_O>
__device__ __forceinline__ void hgrn_full(const bf16* Z, bf16* Y, int row0, int nchunk, int h, float lbk, const float* gn, f32x4 (&S)[4][4], float& dtot, LAS unsigned char* wl, int lane) {
    LAS bf16* Q = (LAS bf16*)wl; LAS bf16* Kt = (LAS bf16*)(wl + 2048); LAS bf16* KT = (LAS bf16*)(wl + 4096); LAS float* Dv = (LAS float*)(wl + 6144);
    const float omlb = 1.f - lbk;
    const bf16* zb = Z + (size_t)row0 * NIN + h * 64;
    bf16* yb = WITH_O ? Y + (size_t)row0 * DM + Y_B + h * 64 : nullptr;
    unsigned rq[16], rf[16];
    {   unsigned la = (unsigned)lane; asm volatile("" : "+v"(la));
#pragma unroll
        for (int t = 0; t < 16; ++t) { rf[t] = WITH_O ? __builtin_nontemporal_load(zb + t * NIN + la + Z_F) : zb[t * NIN + la + Z_F]; if (WITH_O) rq[t] = __builtin_nontemporal_load(zb + t * NIN + la + Z_Q); } }
    for (int c = 0; c < nchunk; ++c, zb += 16 * NIN, yb += 16 * DM) {
        unsigned la = (unsigned)lane; asm volatile("" : "+v"(la));
        const unsigned fr = la & 15u, fq = la >> 4;
        unsigned rv[16], rg[16];
#pragma unroll
        for (int vt = 0; vt < 4; ++vt)
#pragma unroll
            for (int j = 0; j < 4; ++j) { rv[vt * 4 + j] = WITH_O ? __builtin_nontemporal_load(zb + (4 * fq + j) * NIN + Z_I + 16 * vt + fr) : zb[(4 * fq + j) * NIN + Z_I + 16 * vt + fr]; if (WITH_O) rg[vt * 4 + j] = __builtin_nontemporal_load(zb + (4 * fq + j) * NIN + Z_G + 16 * vt + fr); }
        float P = 1.f; unsigned kpk[8];
#pragma unroll
        for (int t = 0; t < 16; ++t) {
            const float zf = bf2f(rf[t]);
            const float e = __expf(-zf), sg = frcp(1.f + e);
            const float f = lbk + omlb * sg, kk = omlb * (e * sg);
            P *= f; const float kin = kk * frcp(P);
            const unsigned kb = f2bf(kin);
            if (WITH_O) { const float zq = bf2f(rq[t]); const float qin = zq * frcp(1.f + __expf(-zq)) * 0.125f * P; Q[t * 64 + la] = (bf16)f2bf(qin); Kt[t * 64 + la] = (bf16)kb; }
            if (t & 1) kpk[t >> 1] |= kb << 16; else kpk[t >> 1] = kb;
        }
        *(LAS u32x4*)(KT + la * 16) = (u32x4){kpk[0], kpk[1], kpk[2], kpk[3]}; *(LAS u32x4*)(KT + la * 16 + 8) = (u32x4){kpk[4], kpk[5], kpk[6], kpk[7]};
        Dv[la] = P; dtot *= P;
        if (c + 1 < nchunk) {
            const bf16* zn = zb + 16 * NIN;
#pragma unroll
            for (int t = 0; t < 16; ++t) { rf[t] = WITH_O ? __builtin_nontemporal_load(zn + t * NIN + la + Z_F) : zn[t * NIN + la + Z_F]; if (WITH_O) rq[t] = __builtin_nontemporal_load(zn + t * NIN + la + Z_Q); } }
        LDS_FENCE();
        s16x4 vB[4];
#pragma unroll
        for (int vt = 0; vt < 4; ++vt) vB[vt] = __builtin_bit_cast(s16x4, (u32x2){rv[vt * 4] | (rv[vt * 4 + 1] << 16), rv[vt * 4 + 2] | (rv[vt * 4 + 3] << 16)});
        f32x4 Dk[4];
#pragma unroll
        for (int kt = 0; kt < 4; ++kt) Dk[kt] = *(const LAS f32x4*)(Dv + 16 * kt + 4 * fq);
        f32x4 o[4];
        if (WITH_O) {
            s16x4 qa[4], ka[4];
#pragma unroll
            for (int kt = 0; kt < 4; ++kt) { qa[kt] = *(const LAS s16x4*)(Q + fr * 64 + 16 * kt + 4 * fq); ka[kt] = *(const LAS s16x4*)(Kt + fr * 64 + 16 * kt + 4 * fq); }
            f32x4 sT = {0.f, 0.f, 0.f, 0.f};
#pragma unroll
            for (int kt = 0; kt < 4; ++kt) sT = __builtin_amdgcn_mfma_f32_16x16x16bf16_1k(ka[kt], qa[kt], sT, 0, 0, 0);
#pragma unroll
            for (int j = 0; j < 4; ++j) if (4 * fq + j > fr) sT[j] = 0.f;
            const s16x4 Pm = __builtin_bit_cast(s16x4, (u32x2){pk2(sT[0], sT[1]), pk2(sT[2], sT[3])});
#pragma unroll
            for (int vt = 0; vt < 4; ++vt) { f32x4 acc = {0.f, 0.f, 0.f, 0.f};
                acc = __builtin_amdgcn_mfma_f32_16x16x16bf16_1k(Pm, vB[vt], acc, 0, 0, 0);
#pragma unroll
                for (int kt = 0; kt < 4; ++kt) { const s16x4 Sb = __builtin_bit_cast(s16x4, (u32x2){pk2(S[kt][vt][0], S[kt][vt][1]), pk2(S[kt][vt][2], S[kt][vt][3])});
                    acc = __builtin_amdgcn_mfma_f32_16x16x16bf16_1k(qa[kt], Sb, acc, 0, 0, 0); }
                o[vt] = acc; }
        }
#pragma unroll
        for (int kt = 0; kt < 4; ++kt) { const s16x4 KTa = *(const LAS s16x4*)(KT + (16 * kt + fr) * 16 + 4 * fq);
#pragma unroll
            for (int vt = 0; vt < 4; ++vt) { S[kt][vt] = __builtin_amdgcn_mfma_f32_16x16x16bf16_1k(KTa, vB[vt], S[kt][vt], 0, 0, 0); S[kt][vt] = S[kt][vt] * Dk[kt]; } }
        if (WITH_O) {
            float gnv[4];
#pragma unroll
            for (int vt = 0; vt < 4; ++vt) gnv[vt] = gn[16 * vt + fr];
#pragma unroll
            for (int j = 0; j < 4; ++j) { float ss = (o[0][j] * o[0][j] + o[1][j] * o[1][j]) + (o[2][j] * o[2][j] + o[3][j] * o[3][j]);
                ss = row16_sum(ss);
                const float rstd = rsqrtf(ss * (1.f / 64.f) + EPS);
#pragma unroll
                for (int vt = 0; vt < 4; ++vt) { const float zg = bf2f(rg[vt * 4 + j]);
                    yb[(4 * fq + j) * DM + 16 * vt + fr] = (bf16)f2bf(o[vt][j] * rstd * gnv[vt] * zg * frcp(1.f + __expf(-zg))); } }
        }
        LDS_FENCE();
    }
}
__device__ __forceinline__ float hgrn_lb(const Args& a, int l, int h, int lane) {
    if (l == 0) return 0.f;
    const float* b = a.in[I_BLB]; return sigmoidf_(b[512 + h * 64 + lane] - b[h * 64 + lane]);
}
__device__ __forceinline__ void zeroS(f32x4 (&S)[4][4]) {
#pragma unroll
    for (int kt = 0; kt < 4; ++kt)
#pragma unroll
        for (int vt = 0; vt < 4; ++vt) S[kt][vt] = (f32x4){0.f, 0.f, 0.f, 0.f};
}
__device__ __forceinline__ void storeS_kv(const f32x4 (&S)[4][4], float* dst, int lane) {
    const int fr = lane & 15, fq = lane >> 4;
#pragma unroll
    for (int kt = 0; kt < 4; ++kt)
#pragma unroll
        for (int vt = 0; vt < 4; ++vt)
#pragma unroll
            for (int j = 0; j < 4; ++j) __builtin_nontemporal_store(S[kt][vt][j], dst + (16 * kt + 4 * fq + j) * 64 + 16 * vt + fr);
}
__device__ __forceinline__ void hgrn_pass1(const Args& a, int l, int unit, LAS unsigned char* wl, int lane) {
    const int j = unit % NSEGS, bh = unit / NSEGS, h = bh & 7, b = bh >> 3;
    f32x4 S[4][4]; zeroS(S); float btot = 1.f;
    hgrn_full<false>((const bf16*)(a.ws + WS_Z), nullptr, b * SEQ + j * HSEG, HCH, h, hgrn_lb(a, l, h, lane), nullptr, S, btot, wl, lane);
    u32x2* L = (u32x2*)(a.ws + WS_SEGL) + (size_t)unit * 1024;
#pragma unroll
    for (int kt = 0; kt < 4; ++kt)
#pragma unroll
        for (int vt = 0; vt < 4; ++vt) L[(kt * 4 + vt) * 64 + lane] = (u32x2){pk2(S[kt][vt][0], S[kt][vt][1]), pk2(S[kt][vt][2], S[kt][vt][3])};
    ((float*)(a.ws + WS_SEGD))[unit * 64 + lane] = btot;
}
__device__ __forceinline__ void hgrn_pass2(const Args& a, int l, int unit, LAS unsigned char* wl, int lane) {
    const int j = unit % NSEGS, bh = unit / NSEGS, h = bh & 7, b = bh >> 3, fq = lane >> 4;
    f32x4 S[4][4]; zeroS(S); float btot = 0.f;
    {
        constexpr int PB = 3;
        const u32x2* Lb = (const u32x2*)(a.ws + WS_SEGL) + (size_t)bh * NSEGS * 1024 + lane; const float* Db = (const float*)(a.ws + WS_SEGD) + bh * NSEGS * 64 + 4 * fq;
        for (int i = 0; i < j; i += PB) {
            u32x2 lr[PB][16]; f32x4 dr[PB][4];
#pragma unroll
            for (int p = 0; p < PB; ++p) { const int ii = (i + p < j) ? i + p : j - 1;
#pragma unroll
                for (int q = 0; q < 16; ++q) lr[p][q] = Lb[(size_t)ii * 1024 + q * 64];
#pragma unroll
                for (int kt = 0; kt < 4; ++kt) dr[p][kt] = *(const f32x4*)(Db + ii * 64 + 16 * kt); }
#pragma unroll
            for (int p = 0; p < PB; ++p) if (i + p < j) {
#pragma unroll
                for (int kt = 0; kt < 4; ++kt)
#pragma unroll
                    for (int vt = 0; vt < 4; ++vt) { float t[4]; unpack4(lr[p][kt * 4 + vt], t); S[kt][vt] = S[kt][vt] * dr[p][kt] + (f32x4){t[0], t[1], t[2], t[3]}; } }
        }
    }
    hgrn_full<true>((const bf16*)(a.ws + WS_Z), (bf16*)(a.ws + WS_YMIX), b * SEQ + j * HSEG, HCH, h, hgrn_lb(a, l, h, lane), a.in[I_BGN] + l * 512 + h * 64, S, btot, wl, lane);
    if (j == NSEGS - 1) storeS_kv(S, a.out + O_HP + ((size_t)(l * NB + b) * 8 + h) * 4096, lane);
}
__device__ __forceinline__ void hgrn_sample(const Args& a, int l, int unit, LAS unsigned char* wl, int lane) {
    const int h = unit & 7, n = unit >> 3, fr = lane & 15, fq = lane >> 4;
    const float* s0 = a.in[I_SH] + ((size_t)(l * NS + n) * 8 + h) * 4096;
    f32x4 S[4][4]; float btot = 0.f;
#pragma unroll
    for (int kt = 0; kt < 4; ++kt)
#pragma unroll
        for (int vt = 0; vt < 4; ++vt)
#pragma unroll
            for (int j = 0; j < 4; ++j) S[kt][vt][j] = __builtin_nontemporal_load(s0 + (16 * kt + 4 * fq + j) * 64 + 16 * vt + fr);
    hgrn_run<true>((const bf16*)(a.ws + WS_Z), (bf16*)(a.ws + WS_YMIX), TP + 4 * n, 1, 4, h, hgrn_lb(a, l, h, lane), a.in[I_BGN] + l * 512 + h * 64, S, btot, wl, lane);
    storeS_kv(S, a.out + O_HS + ((size_t)(l * NS + n) * 8 + h) * 4096, lane);
}


template <int MODE, int K, int NTM = 8, int MT = 4> __device__ __forceinline__ void sgemm_phase(LAS unsigned char* lds, const bf16* A, const bf16* Bt, int N, bf16* O, int ldc, int tid, int wave, int lane, int bid, int G, const float* bias = nullptr, int rowlim = 0) {
    const int fr = lane & 15, fq = lane >> 4, ntiles = NTM * (N >> 6);
    constexpr int kw = K >> 3, NST = kw / 64;
    const bool xmap = (G & 7) == 0; const int nloc = xmap ? ntiles >> 3 : ntiles, jstep = xmap ? G >> 3 : G;
    for (int j = xmap ? bid >> 3 : bid; j < nloc; j += jstep) {
        const int tm = j & (NTM - 1), tn = xmap ? (bid & 7) + 8 * (j / NTM) : j / NTM;
        const bf16* Ap = A + (size_t)(tm * (16 * MT) + fr) * K + wave * kw + 16 * fq;
        const bf16* Bp = Bt + (size_t)(tn * 64 + fr) * K + wave * kw + 16 * fq;
        f32x4 acc[MT][4];
#pragma unroll
        for (int m = 0; m < MT; ++m)
#pragma unroll
            for (int n = 0; n < 4; ++n) acc[m][n] = (f32x4){0.f, 0.f, 0.f, 0.f};
        s16x8 a0[MT], a1[MT], b0[4], b1[4];
#pragma unroll
        for (int m = 0; m < MT; ++m) { a0[m] = *(const s16x8*)(Ap + (size_t)m * 16 * K); a1[m] = *(const s16x8*)(Ap + (size_t)m * 16 * K + 8); }
#pragma unroll
        for (int n = 0; n < 4; ++n) { b0[n] = *(const s16x8*)(Bp + (size_t)n * 16 * K); b1[n] = *(const s16x8*)(Bp + (size_t)n * 16 * K + 8); }
#pragma unroll
        for (int st = 0; st < NST; ++st) {
            s16x8 na0[MT], na1[MT], nb0[4], nb1[4];
            if (st + 1 < NST) {
                const int k = (st + 1) * 64;
#pragma unroll
                for (int m = 0; m < MT; ++m) { na0[m] = *(const s16x8*)(Ap + (size_t)m * 16 * K + k); na1[m] = *(const s16x8*)(Ap + (size_t)m * 16 * K + k + 8); }
#pragma unroll
                for (int n = 0; n < 4; ++n) { nb0[n] = *(const s16x8*)(Bp + (size_t)n * 16 * K + k); nb1[n] = *(const s16x8*)(Bp + (size_t)n * 16 * K + k + 8); }
            }
#pragma unroll
            for (int m = 0; m < MT; ++m)
#pragma unroll
                for (int n = 0; n < 4; ++n) { acc[m][n] = __builtin_amdgcn_mfma_f32_16x16x32_bf16(b0[n], a0[m], acc[m][n], 0, 0, 0); acc[m][n] = __builtin_amdgcn_mfma_f32_16x16x32_bf16(b1[n], a1[m], acc[m][n], 0, 0, 0); }
            if (st + 1 < NST) {
#pragma unroll
                for (int m = 0; m < MT; ++m) { a0[m] = na0[m]; a1[m] = na1[m]; }
#pragma unroll
                for (int n = 0; n < 4; ++n) { b0[n] = nb0[n]; b1[n] = nb1[n]; }
            }
        }
        LAS f32x4* red = (LAS f32x4*)lds + wave * 1024;
#pragma unroll
        for (int m = 0; m < MT; ++m)
#pragma unroll
            for (int n = 0; n < 4; ++n) red[(16 * m + fr) * 16 + ((4 * n + fq) ^ fr)] = acc[m][n];
        __syncthreads();
        const int row = tid >> 3, c4 = (tid & 7) * 2;
        if (tid < 128 * MT) {
        f32x4 s0 = {0.f, 0.f, 0.f, 0.f}, s1 = {0.f, 0.f, 0.f, 0.f};
#pragma unroll
        for (int w = 0; w < 8; ++w) { const LAS f32x4* r = (const LAS f32x4*)lds + w * 1024 + row * 16; s0 += r[c4 ^ (row & 15)]; s1 += r[(c4 + 1) ^ (row & 15)]; }
        if (MODE == 1) {
#pragma unroll
            for (int e = 0; e < 4; ++e) { const float x = s0[e] > 0.f ? s0[e] : 0.f; s0[e] = x * x; const float y = s1[e] > 0.f ? s1[e] : 0.f; s1[e] = y * y; } }
        if (MODE == 2) { const int col = tn * 64 + 4 * c4;
            if (tm * (16 * MT) + row < rowlim) { float* p = (float*)O + (size_t)(tm * (16 * MT) + row) * ldc + col; *(f32x4*)p = s0 + *(const f32x4*)(bias + col); *(f32x4*)(p + 4) = s1 + *(const f32x4*)(bias + col + 4); }
        } else {
        u32x4 w; w.x = pk2(s0[0], s0[1]); w.y = pk2(s0[2], s0[3]); w.z = pk2(s1[0], s1[1]); w.w = pk2(s1[2], s1[3]);
        *(u32x4*)(O + (size_t)(tm * (16 * MT) + row) * ldc + tn * 64 + 4 * c4) = w; }
        }
        __syncthreads();
    }
}


__device__ __forceinline__ void ada_phase(LAS unsigned char* lds, const Args& a, int tid, int wave, int lane, int bid, int G) {
    const int fr = lane & 15, fq = lane >> 4;
    constexpr int K = DM, kw = K / 8, NT = 3 * (2 * 6 * DM / 64);
    for (int tile = bid; tile < NT; tile += G) {
        const int tm = tile % 3, tn = tile / 3, l = tn / 96, nloc = (tn % 96) * 64;
        const float* W = a.in[I_WADA] + (size_t)l * DM * 6 * DM + (size_t)(wave * kw + 16 * fq) * (6 * DM) + nloc + fr;
        f32x4 acc[4][4];
#pragma unroll
        for (int m = 0; m < 4; ++m)
#pragma unroll
            for (int n = 0; n < 4; ++n) acc[m][n] = (f32x4){0.f, 0.f, 0.f, 0.f};
#pragma unroll
        for (int st = 0; st < kw / 64; ++st) {
            float bw[4][16];
#pragma unroll
            for (int n = 0; n < 4; ++n)
#pragma unroll
                for (int i = 0; i < 16; ++i) bw[n][i] = W[(size_t)(st * 64 + i) * (6 * DM) + 16 * n];
            s16x8 a0[4], a1[4];
#pragma unroll
            for (int m = 0; m < 4; ++m) { int row = tm * 64 + 16 * m + fr; row = row < NSEQ ? row : NSEQ - 1;
                const float* c = (row < NB ? a.in[I_CP] + (size_t)row * DM : a.in[I_CS] + (size_t)(row - NB) * DM) + wave * kw + st * 64 + 16 * fq;
                const f32x4 c0 = *(const f32x4*)c, c1 = *(const f32x4*)(c + 4), c2 = *(const f32x4*)(c + 8), c3 = *(const f32x4*)(c + 12);
                u32x4 p0, p1; p0.x = pk2(siluf_(c0[0]), siluf_(c0[1])); p0.y = pk2(siluf_(c0[2]), siluf_(c0[3])); p0.z = pk2(siluf_(c1[0]), siluf_(c1[1])); p0.w = pk2(siluf_(c1[2]), siluf_(c1[3]));
                p1.x = pk2(siluf_(c2[0]), siluf_(c2[1])); p1.y = pk2(siluf_(c2[2]), siluf_(c2[3])); p1.z = pk2(siluf_(c3[0]), siluf_(c3[1])); p1.w = pk2(siluf_(c3[2]), siluf_(c3[3]));
                a0[m] = __builtin_bit_cast(s16x8, p0); a1[m] = __builtin_bit_cast(s16x8, p1); }
#pragma unroll
            for (int n = 0; n < 4; ++n) {
                u32x4 q0, q1; q0.x = pk2(bw[n][0], bw[n][1]); q0.y = pk2(bw[n][2], bw[n][3]); q0.z = pk2(bw[n][4], bw[n][5]); q0.w = pk2(bw[n][6], bw[n][7]);
                q1.x = pk2(bw[n][8], bw[n][9]); q1.y = pk2(bw[n][10], bw[n][11]); q1.z = pk2(bw[n][12], bw[n][13]); q1.w = pk2(bw[n][14], bw[n][15]);
                const s16x8 b0 = __builtin_bit_cast(s16x8, q0), b1 = __builtin_bit_cast(s16x8, q1);
#pragma unroll
                for (int m = 0; m < 4; ++m) { acc[m][n] = __builtin_amdgcn_mfma_f32_16x16x32_bf16(b0, a0[m], acc[m][n], 0, 0, 0); acc[m][n] = __builtin_amdgcn_mfma_f32_16x16x32_bf16(b1, a1[m], acc[m][n], 0, 0, 0); } }
        }
        LAS f32x4* red = (LAS f32x4*)lds + wave * 1024;
#pragma unroll
        for (int m = 0; m < 4; ++m)
#pragma unroll
            for (int n = 0; n < 4; ++n) red[(16 * m + fr) * 16 + ((4 * n + fq) ^ fr)] = acc[m][n];
        __syncthreads();
        const int row = tid >> 3, c4 = (tid & 7) * 2;
        f32x4 s0 = {0.f, 0.f, 0.f, 0.f}, s1 = {0.f, 0.f, 0.f, 0.f};
#pragma unroll
        for (int w = 0; w < 8; ++w) { const LAS f32x4* r = (const LAS f32x4*)lds + w * 1024 + row * 16; s0 += r[c4 ^ (row & 15)]; s1 += r[(c4 + 1) ^ (row & 15)]; }
        const int col = tn * 64 + 4 * c4;
        if (tm * 64 + row < NSEQ) { float* p = (float*)(a.ws + WS_MOD) + (size_t)(tm * 64 + row) * MODLD + col; const float* bias = a.in[I_BADA] + col;
            *(f32x4*)p = s0 + *(const f32x4*)bias; *(f32x4*)(p + 4) = s1 + *(const f32x4*)(bias + 4); }
        __syncthreads();
    }
}

#define RLX_AGENT __ATOMIC_RELAXED, __HIP_MEMORY_SCOPE_AGENT
#define XB_TMO      128
#define XB_XCNT(j)  (256  + 64 * (j))
#define XB_XSUB(j)  (1280 + 64 * (j))
#define XB_XGEN(j)  (2304 + 64 * (j))
#define XB_TOP      3328
#define XB_TOPGEN   3392
#define XCD_BAR_WORDS 3456
#define XB_SPIN_CAP (1u << 18)

__device__ __forceinline__ unsigned xb_ld(unsigned* p)              { return __hip_atomic_load(p, __ATOMIC_RELAXED, __HIP_MEMORY_SCOPE_AGENT); }
__device__ __forceinline__ unsigned xb_add(unsigned* p, unsigned v) { return __hip_atomic_fetch_add(p, v, __ATOMIC_RELAXED, __HIP_MEMORY_SCOPE_AGENT); }
__device__ __forceinline__ unsigned xb_xcc_id() { return (unsigned)__builtin_amdgcn_s_getreg((3 << 11) | 20) & 0xFu; }
#define XB_SPIN(cond, bar) do { unsigned _sp = 0; while (cond) { __builtin_amdgcn_s_sleep(1); \
    if ((++_sp & 255u) == 0u) { if (xb_ld(&(bar)[XB_TMO])) break; if (_sp > XB_SPIN_CAP) { atomicAdd(&(bar)[XB_TMO], 1u); break; } } } } while (0)

struct XcdBarrier {
    unsigned* bar; unsigned x;
    volatile LAS unsigned* st;
};

__device__ __forceinline__ XcdBarrier xcd_barrier_post(unsigned* bar, volatile LAS unsigned* st) {
    XcdBarrier b; b.bar = bar; b.x = xb_xcc_id(); b.st = st;
    if (threadIdx.x == 0) (void)xb_add(&bar[XB_XCNT(b.x)], 1u);
    return b;
}
__device__ __forceinline__ void xcd_barrier_complete(unsigned* bar, unsigned x, unsigned& nloc, unsigned& nx) {
    const unsigned G = gridDim.x * gridDim.y * gridDim.z;
    unsigned sum, cnt, mine, sp = 0u;
    for (;;) {
        sum = 0u; cnt = 0u; mine = 0u;
#pragma unroll
        for (unsigned j = 0; j < 16; ++j) { const unsigned c = xb_ld(&bar[XB_XCNT(j)]); sum += c; cnt += (c > 0u) ? 1u : 0u; mine = (j == x) ? c : mine; }
        if (sum == G) break;
        __builtin_amdgcn_s_sleep(1);
        if ((++sp & 255u) == 0u) { if (xb_ld(&bar[XB_TMO])) break; if (sp > XB_SPIN_CAP) { atomicAdd(&bar[XB_TMO], 1u); break; } }
    }
    nloc = mine > 0u ? mine : 1u; nx = cnt > 0u ? cnt : 1u;
}

__device__ __forceinline__ void xcd_barrier(const XcdBarrier& b) {
    asm volatile("s_waitcnt vmcnt(0)" ::: "memory");
    __syncthreads();
    if (threadIdx.x == 0) {
        unsigned* bar = b.bar;
        __builtin_amdgcn_s_waitcnt(0);
        unsigned nloc = b.st[0], nx = b.st[1];
        if (nloc == 0u) { xcd_barrier_complete(bar, b.x, nloc, nx); b.st[0] = nloc; b.st[1] = nx; }
        const unsigned old = xb_add(&bar[XB_XSUB(b.x)], 1u);
        const unsigned gen = old / nloc;
        if (old + 1u == (gen + 1u) * nloc) {
            __builtin_amdgcn_fence(__ATOMIC_RELEASE, "agent");
            asm volatile("s_waitcnt vmcnt(0)" ::: "memory");
            const unsigned og = xb_add(&bar[XB_TOP], 1u);
            const unsigned tg = og / nx;
            if (og + 1u == (tg + 1u) * nx) xb_add(&bar[XB_TOPGEN], 1u);
            else XB_SPIN(xb_ld(&bar[XB_TOPGEN]) == tg, bar);
            __builtin_amdgcn_fence(__ATOMIC_ACQUIRE, "agent");
            xb_add(&bar[XB_XGEN(b.x)], 1u);
            asm volatile("s_waitcnt vmcnt(0)" ::: "memory");
        } else {
            XB_SPIN(xb_ld(&bar[XB_XGEN(b.x)]) == gen, bar);
            __builtin_amdgcn_fence(__ATOMIC_ACQUIRE, "agent");
            asm volatile("s_waitcnt vmcnt(0)" ::: "memory");
        }
    }
    __syncthreads();
}

constexpr int CW_BAR = 4096, LDS_MISC_OFF = 131072 + 64;
#define GSYNC() xcd_barrier(xbar)

__device__ __forceinline__ Args load_args() {
#if defined(__HIP_DEVICE_COMPILE__)
    const __attribute__((address_space(4))) void* p = (const __attribute__((address_space(4))) void*)__builtin_amdgcn_kernarg_segment_ptr(); asm volatile("" : "+s"(p));
    const __attribute__((address_space(4))) Args* q = (const __attribute__((address_space(4))) Args*)p;
    Args r;
#pragma unroll
    for (int i = 0; i < 26; ++i) r.in[i] = q->in[i];
    r.out = q->out; r.ws = q->ws; return r;
#else
    return Args{};
#endif
}
#define PH_IDS() int tid = threadIdx.x; asm volatile("" : "+v"(tid)); const int lane = tid & 63, wave = __builtin_amdgcn_readfirstlane(tid >> 6); \
    const int G = gridDim.x, bid = blockIdx.x, gw = bid * NWAVES + wave, NGW = G * NWAVES; const Args a = load_args(); unsigned char* ws = a.ws; \
    (void)lane; (void)wave; (void)gw; (void)NGW; (void)ws; (void)G; (void)bid;
template <int MODE> __device__ __forceinline__ void run_gemm(LAS unsigned char* lds, const void* A, const void* Bt, int M, int N, int K, void* O, int ldc, const float* bias, int rowlim) {
    pg8::Gemm g{(const pg8::bf16_t*)A, (const pg8::bf16_t*)Bt, M, N, K}; pg8::StaticOrder S; S.init(M, N, (int)gridDim.x, (int)blockIdx.x);
    pg8::EpiT<MODE> E{O, ldc, bias, rowlim};
    pg8::gemm_phase<pg8::EpiT<MODE>, pg8::StaticOrder, true, true>(lds, g, S, E);
}
template <int L> __device__ __forceinline__ void layer_body(LAS unsigned char* lds, const XcdBarrier& xbar) {
    constexpr int l = L;
    { PH_IDS(); run_gemm<0>(lds, ws + WS_HY, (const bf16*)(ws + WS_WIN) + (size_t)l * NIN * DM, TP, NIN, DM, ws + WS_Z, NIN, nullptr, 0); }
    { PH_IDS(); sgemm_phase<0, DM>(lds, (const bf16*)(ws + WS_HY) + (size_t)TP * DM, (const bf16*)(ws + WS_WIN) + (size_t)l * NIN * DM, NIN, (bf16*)(ws + WS_Z) + (size_t)TP * NIN, NIN, tid, wave, lane, bid, G); }
    GSYNC();
    {
        PH_IDS();
        constexpr int N_CONVP = NB * (SEQ / 64), N_CONVS = NS;
#ifndef NO_CONV
        for (int it = bid; it < N_CONVP + N_CONVS; it += G) {
            if (it < N_CONVP) conv_item(a, l, it / (SEQ / 64), (it % (SEQ / 64)) * 64, 64, lds, tid, wave, lane);
            else conv_item(a, l, NB + (it - N_CONVP), 0, 4, lds, tid, wave, lane);
        }
#endif
    }
    {   PH_IDS();
#ifndef NO_GMLP
        for (int it = G - 1 - bid; it < 2 * (TP / 128); it += G) { if (it & 1) gmlp_chunk<1>(a, l, it >> 1, lds, wave, lane); else gmlp_chunk<0>(a, l, it >> 1, lds, wave, lane); }
#endif
    }
    {   PH_IDS();
        LAS unsigned char* wl = lds + wave * 8192;
#ifndef NO_HGRN
        if (wave < 4) { for (int it = wave * G + bid; it < NB * 8 * NSEGS; it += 4 * G) hgrn_pass1(a, l, it, wl, lane); }
        else { for (int it = (wave - 4) * G + bid; it < NS * 8; it += 4 * G) hgrn_sample(a, l, it, wl, lane);
               for (int it = (wave - 4) * G + bid; it < N_LATE0; it += 4 * G) late_item(a, l, it, lane); }
#endif
    }
    {   PH_IDS();
#ifndef NO_GMLP
        for (int it = NGW - 1 - gw; it < NS; it += NGW) gmlp_sample(a, l, it, lane);
#endif
    }
    GSYNC();
    {
        PH_IDS();
        LAS unsigned char* wl = lds + wave * 8192;
#ifndef NO_HGRN
        for (int it = wave * G + bid; it < NB * 8 * NSEGS; it += NWAVES * G) hgrn_pass2(a, l, it, wl, lane);
        if (l == 0 && wave >= 4) for (int it = (wave - 4) * G + bid; it < I_IN; it += 4 * G) late_item(a, 2, it, lane);
#endif
    }
    GSYNC();
    { PH_IDS(); run_gemm<0>(lds, ws + WS_YMIX, (const bf16*)(ws + WS_WOUT) + (size_t)l * DM * DM, TP, DM, DM, ws + WS_HY, DM, nullptr, 0); }
    { PH_IDS(); sgemm_phase<0, DM, 16, 2>(lds, (const bf16*)(ws + WS_YMIX) + (size_t)TP * DM, (const bf16*)(ws + WS_WOUT) + (size_t)l * DM * DM, DM, (bf16*)(ws + WS_HY) + (size_t)TP * DM, DM, tid, wave, lane, G - 1 - bid, G); }
    GSYNC();
    { PH_IDS(); postnorm_phase<L, 0>(a, gw, NGW, lane); }
#ifndef SKIP_MLP
    GSYNC();
    { PH_IDS(); run_gemm<1>(lds, ws + WS_HY, (const bf16*)(ws + WS_WUP) + (size_t)l * DFF * DM, TP, DFF, DM, ws + WS_U, DFF, nullptr, 0); }
    { PH_IDS(); sgemm_phase<1, DM>(lds, (const bf16*)(ws + WS_HY) + (size_t)TP * DM, (const bf16*)(ws + WS_WUP) + (size_t)l * DFF * DM, DFF, (bf16*)(ws + WS_U) + (size_t)TP * DFF, DFF, tid, wave, lane, bid, G); }
    GSYNC();
    { PH_IDS(); run_gemm<0>(lds, ws + WS_U, (const bf16*)(ws + WS_WDN) + (size_t)l * DM * DFF, TP, DM, DFF, ws + WS_HY, DM, nullptr, 0); }
    { PH_IDS(); sgemm_phase<0, DFF, 16, 2>(lds, (const bf16*)(ws + WS_U) + (size_t)TP * DFF, (const bf16*)(ws + WS_WDN) + (size_t)l * DM * DFF, DM, (bf16*)(ws + WS_HY) + (size_t)TP * DM, DM, tid, wave, lane, G - 1 - bid, G); }
    GSYNC();
    { PH_IDS(); postnorm_phase<L, 1>(a, gw, NGW, lane); }
#endif
}
__global__ void __launch_bounds__(NWAVES * 64, 2) fwd_kernel(Args a_unused) {
    extern __shared__ __attribute__((aligned(16))) unsigned char lds_raw[];
    LAS unsigned char* lds = (LAS unsigned char*)lds_raw;
    cg::grid_group grid = cg::this_grid();
    XcdBarrier xbar;
    {   PH_IDS();
        if (tid < 16) ((LAS unsigned*)(lds + LDS_MISC_OFF))[tid] = 0u;
        __syncthreads();
        xbar = xcd_barrier_post((unsigned*)ws + CW_BAR, (volatile LAS unsigned*)(lds + LDS_MISC_OFF));
    }
    asm volatile("s_waitcnt vmcnt(0)" ::: "memory");
    grid.sync();
    { PH_IDS(); p0_prologue(a, lds, NGW - 1 - gw, NGW, wave, lane); }
    { PH_IDS(); ada_phase(lds, a, tid, wave, lane, bid, G); }
    GSYNC();
    { PH_IDS(); prenorm0_phase(a, gw, NGW, lane); }
    GSYNC();
    layer_body<0>(lds, xbar);
#ifndef ONLY_L0
    GSYNC();
    layer_body<1>(lds, xbar);
#endif
}

extern "C" void kernel_launch(void* const* d_in, const int* in_sizes, int n_in, void* d_out, int out_size, void* d_ws, size_t ws_size, hipStream_t stream) {
    static int grid = 0;
    if (grid == 0) {
        if (n_in != 26 || ws_size < WS_END) { fprintf(stderr, "kernel_launch: unexpected n_in %d / ws_size %zu\n", n_in, ws_size); grid = -1; return; }
        int dev = 0, cus = 0, per_cu = 0;
        (void)hipGetDevice(&dev); (void)hipDeviceGetAttribute(&cus, hipDeviceAttributeMultiprocessorCount, dev);
        (void)hipFuncSetAttribute((const void*)fwd_kernel, hipFuncAttributeMaxDynamicSharedMemorySize, LDS_BYTES);
        (void)hipOccupancyMaxActiveBlocksPerMultiprocessor(&per_cu, (const void*)fwd_kernel, NWAVES * 64, LDS_BYTES);
        if (per_cu < 1) { fprintf(stderr, "kernel_launch: occupancy query says %d blocks/CU\n", per_cu); per_cu = 1; }
        grid = cus;
        fprintf(stderr, "kernel_launch: grid %d (cus %d, per_cu %d), ws %zu\n", grid, cus, per_cu, ws_size);
    }
    if (grid < 0) return;
    (void)hipMemsetAsync(d_ws, 0, 65536, stream);
    Args a{};
    for (int i = 0; i < 26; ++i) a.in[i] = (const float*)d_in[i];
    a.out = (float*)d_out; a.ws = (unsigned char*)d_ws;
    void* args[] = {&a};
    hipError_t e = hipLaunchCooperativeKernel((const void*)fwd_kernel, dim3(grid), dim3(NWAVES * 64), args, LDS_BYTES, stream);
    if (e != hipSuccess) fprintf(stderr, "kernel_launch: cooperative launch failed: %s\n", hipGetErrorString(e));
}
```

```cpp
#include <hip/hip_runtime.h>
#include <hip/hip_cooperative_groups.h>
#include <cstdio>
#include <cstdint>
namespace cg = cooperative_groups;
namespace pg8 {
#define PG8_LAS __attribute__((address_space(3)))
typedef unsigned short bf16_t;
typedef short bf16x8 __attribute__((ext_vector_type(8)));
typedef float f32x4 __attribute__((ext_vector_type(4)));
typedef unsigned u32x4 __attribute__((ext_vector_type(4)));
constexpr int BM = 256, BK = 64, HALF = 128, HTB = HALF * BK * 2  , STAGE_BYTES = 8 * HTB, NXCD = 8, WGM = 8;

__host__ __device__ __forceinline__ int lds_byte(int r, int c) { const int st = (r >> 4) * 2 + (c >> 5), rr = r & 15, cc = c & 31, ob = rr * 64 + cc * 2; return st * 1024 + (ob ^ (((ob >> 9) & 1) << 5)); }
__host__ __device__ __forceinline__ void stage_rc(int b, int& R, int& C) { const int st = b / 1024, sb = b % 1024, swz = sb ^ (((sb >> 9) & 1) << 5); R = (st >> 1) * 16 + swz / 64; C = (st & 1) * 32 + (swz % 64) / 2; }
__host__ __device__ __forceinline__ int perm32(int rho) { const int n = rho >> 4, i = rho & 15; return 8 * (i >> 2) + 4 * n + (i & 3); }

struct Unit { int pm, pn; };
struct Gemm { const bf16_t* A; const bf16_t* Bt; int M, N, K; };

struct StaticOrder {
    int nM, nN, nwg, G, c;
    __host__ __device__ void init(int M, int N, int G_, int c_) { nM = M / BM; nN = N / BM; nwg = nM * nN; G = G_; c = c_; }
    __host__ __device__ bool next(int i, Unit& u) const {
        const long L = (long)i * G + c; if (L >= nwg) return false;
        int wgid = (int)L; { const int q = nwg / NXCD, r = nwg % NXCD, xcd = wgid % NXCD, off = wgid / NXCD; wgid = (xcd < r ? xcd * (q + 1) : r * (q + 1) + (xcd - r) * q) + off; }
        const int nig = WGM * nN, gid = wgid / nig, fm = gid * WGM, gsz = (nM - fm) < WGM ? (nM - fm) : WGM;
        u.pm = fm + ((wgid % nig) % gsz); u.pn = (wgid % nig) / gsz; return true;
    }
    __device__ __forceinline__ void a_ready(const Unit&) const {}
    __device__ __forceinline__ void done(const Unit&) const {}
};

__device__ __forceinline__ unsigned cvt_pk_bf16(float lo, float hi) { unsigned r; asm volatile("v_cvt_pk_bf16_f32 %0, %1, %2" : "=v"(r) : "v"(lo), "v"(hi)); return r; }
typedef float f32x2 __attribute__((ext_vector_type(2)));
template <int MODE> struct EpiT {
    static constexpr bool PERM = true, AFTER_DRAIN = false;
    void* O; int ldc; const float* bias; int rowlim;
    __device__ __forceinline__ void operator()(const f32x4 (&acc)[2][2][4][2], const Unit& u, int wr, int wc, int fr, int fq) const {
        const int row0 = u.pm * BM + wr * 64 + fr; const int col0 = u.pn * BM + wc * 32 + 8 * fq;
#pragma unroll
        for (int ai = 0; ai < 2; ++ai)
#pragma unroll
            for (int m = 0; m < 4; ++m) { const int row = row0 + ai * HALF + m * 16;
#pragma unroll
                for (int bj = 0; bj < 2; ++bj) { f32x4 v0 = acc[ai][bj][m][0], v1 = acc[ai][bj][m][1]; const int col = col0 + bj * HALF;
                    if (MODE == 2) {
                        if (row < rowlim) { const f32x4 b0 = *(const f32x4*)(bias + col), b1 = *(const f32x4*)(bias + col + 4);
                            float* p = (float*)O + (size_t)row * ldc + col; *(f32x4*)p = v0 + b0; *(f32x4*)(p + 4) = v1 + b1; }
                    } else {
                        if (MODE == 1) {
#pragma unroll
                            for (int e = 0; e < 4; ++e) { float a = v0[e] > 0.f ? v0[e] : 0.f; v0[e] = a * a; float b = v1[e] > 0.f ? v1[e] : 0.f; v1[e] = b * b; } }
                        u32x4 w; w.x = cvt_pk_bf16(v0[0], v0[1]); w.y = cvt_pk_bf16(v0[2], v0[3]); w.z = cvt_pk_bf16(v1[0], v1[1]); w.w = cvt_pk_bf16(v1[2], v1[3]);
                        *(u32x4*)((bf16_t*)O + (size_t)row * ldc + col) = w; } } }
    }
};
template <class Epi, class Sched, bool ALIGN_EPI = false, bool SP2 = false>
__device__ __forceinline__ void gemm_phase(PG8_LAS unsigned char* lds, const Gemm g, const Sched& S, const Epi& E) {
    const int tid = threadIdx.x, wid = __builtin_amdgcn_readfirstlane(tid >> 6), lane = tid & 63, wr = wid >> 2, wc = wid & 3, fr = lane & 15, fq = lane >> 4;
    const int K = g.K, nt = K / BK;
    unsigned voffA[2], voffB[2];
#pragma unroll
    for (int i = 0; i < 2; ++i) { int R, C; stage_rc(tid * 16 + i * 8192, R, C); const int Rb = Epi::PERM ? ((R & ~31) + perm32(R & 31)) : R;
        voffA[i] = (unsigned)(R * K + C) * 2u; voffB[i] = (unsigned)(Rb * K + C) * 2u; }
    const size_t kstep = (size_t)(BK * 2);
    const size_t hstep = (size_t)HALF * K * 2;
    const size_t tstep = 2 * hstep;
    const unsigned ldsw = (unsigned)wid * 1024u;
    const int aoff = lds_byte(wr * 64 + fr, fq * 8), boff = lds_byte(wc * 32 + fr, fq * 8);
#define PG8_SA(b, h) (((b) * 2 + (h)) * HTB)
#define PG8_SB(b, h) ((4 + (b) * 2 + (h)) * HTB)
#define PG8_STAGE(bufoff, gbase, voff) do { _Pragma("unroll") for (int _i = 0; _i < 2; ++_i) \
        __builtin_amdgcn_global_load_lds((const unsigned*)((const char*)(gbase) + (voff)[_i]), (PG8_LAS unsigned*)(lds + (bufoff) + ldsw + _i * 8192), 16, 0, 0); } while (0)
#define PG8_LDA(dst, b, h) do { _Pragma("unroll") for (int m = 0; m < 4; ++m) _Pragma("unroll") for (int k = 0; k < 2; ++k) dst[m][k] = *(const PG8_LAS bf16x8*)(lds + PG8_SA(b, h) + aoff + m * 2048 + k * 1024); } while (0)
#define PG8_LDB(dst, b, h) do { _Pragma("unroll") for (int n = 0; n < 2; ++n) _Pragma("unroll") for (int k = 0; k < 2; ++k) dst[n][k] = *(const PG8_LAS bf16x8*)(lds + PG8_SB(b, h) + boff + n * 2048 + k * 1024); } while (0)
#define PG8_MMA(ai, bj, At, Bt) do { __builtin_amdgcn_s_setprio(1); _Pragma("unroll") for (int m = 0; m < 4; ++m) _Pragma("unroll") for (int n = 0; n < 2; ++n) _Pragma("unroll") for (int k = 0; k < 2; ++k) \
        acc[ai][bj][m][n] = __builtin_amdgcn_mfma_f32_16x16x32_bf16(Bt[n][k], At[m][k], acc[ai][bj][m][n], 0, 0, 0); __builtin_amdgcn_s_setprio(0); } while (0)
#define PG8_WAIT_V(n) asm volatile("s_waitcnt vmcnt(" #n ")" ::: "memory")
#define PG8_WAIT_L(n) asm volatile("s_waitcnt lgkmcnt(" #n ")" ::: "memory")
#define PG8_BAR __builtin_amdgcn_s_barrier()
#define PG8_SCHED __builtin_amdgcn_sched_barrier(0)
    Unit cur, nxt; int ui = 0;
    if (!S.next(0, cur)) return;
    f32x4 acc[2][2][4][2];
#pragma unroll
    for (int a = 0; a < 2; ++a)
#pragma unroll
        for (int b = 0; b < 2; ++b)
#pragma unroll
            for (int m = 0; m < 4; ++m)
#pragma unroll
                for (int n = 0; n < 2; ++n) acc[a][b][m][n] = (f32x4){0.f, 0.f, 0.f, 0.f};
    bf16x8 At[4][2], B0[2][2], B1[2][2];
    const char* cA = (const char*)g.A + (size_t)cur.pm * tstep; const char* cB = (const char*)g.Bt + (size_t)cur.pn * tstep;
    S.a_ready(cur);
    if constexpr (SP2) {
        PG8_STAGE(PG8_SB(0, 0), cB, voffB); PG8_STAGE(PG8_SB(0, 1), cB + hstep, voffB); PG8_STAGE(PG8_SA(0, 0), cA, voffA); PG8_STAGE(PG8_SA(0, 1), cA + hstep, voffA);
        if (wr == 1) PG8_BAR;
        PG8_WAIT_V(2); PG8_BAR;
        PG8_STAGE(PG8_SB(1, 0), cB + kstep, voffB); PG8_STAGE(PG8_SA(1, 0), cA + kstep, voffA); PG8_STAGE(PG8_SB(1, 1), cB + hstep + kstep, voffB);
        PG8_WAIT_V(6); PG8_BAR;
    } else {
        PG8_STAGE(PG8_SB(0, 0), cB, voffB); PG8_STAGE(PG8_SA(0, 0), cA, voffA); PG8_STAGE(PG8_SB(0, 1), cB + hstep, voffB); PG8_STAGE(PG8_SA(0, 1), cA + hstep, voffA);
        if (wr == 1) PG8_BAR;
        PG8_WAIT_V(4); PG8_BAR;
        PG8_STAGE(PG8_SB(1, 0), cB + kstep, voffB); PG8_STAGE(PG8_SA(1, 0), cA + kstep, voffA); PG8_STAGE(PG8_SB(1, 1), cB + hstep + kstep, voffB);
        PG8_WAIT_V(6); PG8_BAR;
    }
    for (;;) {
        const bool has_next = S.next(ui + 1, nxt);
        const char* nA = has_next ? (const char*)g.A + (size_t)nxt.pm * tstep : cA; const char* nB = has_next ? (const char*)g.Bt + (size_t)nxt.pn * tstep : cB;
        for (int t = 0; t < nt; t += 2) {
            const bool last = (t == nt - 2);
            const char* a1 = cA + (size_t)(t + 1) * kstep;
            const char* a2 = last ? nA : cA + (size_t)(t + 2) * kstep; const char* b2 = last ? nB : cB + (size_t)(t + 2) * kstep;
            const char* a3 = a2 + kstep; const char* b3 = b2 + kstep;
            if (last && has_next) S.a_ready(nxt);
            if constexpr (SP2) {
            PG8_LDB(B0, 0, 0); PG8_LDB(B1, 0, 1); PG8_SCHED; PG8_LDA(At, 0, 0); PG8_STAGE(PG8_SA(1, 1), a1 + hstep, voffA);
            PG8_WAIT_V(8); PG8_WAIT_L(0); PG8_BAR; PG8_MMA(0, 0, At, B0); PG8_MMA(0, 1, At, B1); PG8_BAR; PG8_SCHED;
            PG8_LDA(At, 0, 1); PG8_STAGE(PG8_SB(0, 0), b2, voffB); PG8_STAGE(PG8_SB(0, 1), b2 + hstep, voffB); PG8_STAGE(PG8_SA(0, 0), a2, voffA);
            PG8_WAIT_V(8); PG8_WAIT_L(0); PG8_BAR; PG8_MMA(1, 0, At, B0); PG8_MMA(1, 1, At, B1); PG8_BAR; PG8_SCHED;
            PG8_LDB(B0, 1, 0); PG8_LDB(B1, 1, 1); PG8_SCHED; PG8_LDA(At, 1, 0); PG8_STAGE(PG8_SA(0, 1), a2 + hstep, voffA);
            PG8_WAIT_V(8); PG8_WAIT_L(0); PG8_BAR; PG8_MMA(0, 0, At, B0); PG8_MMA(0, 1, At, B1); PG8_BAR; PG8_SCHED;
            PG8_LDA(At, 1, 1); PG8_STAGE(PG8_SB(1, 0), b3, voffB); PG8_STAGE(PG8_SB(1, 1), b3 + hstep, voffB); PG8_STAGE(PG8_SA(1, 0), a3, voffA);
            PG8_WAIT_V(8); PG8_WAIT_L(0); PG8_BAR; PG8_MMA(1, 0, At, B0); PG8_MMA(1, 1, At, B1); PG8_BAR; PG8_SCHED;
            } else {
            PG8_LDB(B0, 0, 0); PG8_SCHED; PG8_LDA(At, 0, 0); PG8_STAGE(PG8_SA(1, 1), a1 + hstep, voffA);
            PG8_WAIT_L(8); PG8_BAR; PG8_WAIT_L(0); PG8_MMA(0, 0, At, B0); PG8_BAR; PG8_SCHED;
            PG8_LDB(B1, 0, 1); PG8_STAGE(PG8_SB(0, 0), b2, voffB);
            PG8_BAR; PG8_WAIT_L(0); PG8_MMA(0, 1, At, B1); PG8_BAR;
            PG8_LDA(At, 0, 1); PG8_STAGE(PG8_SA(0, 0), a2, voffA);
            PG8_BAR; PG8_WAIT_L(0); PG8_MMA(1, 0, At, B0); PG8_BAR; PG8_SCHED;
            PG8_STAGE(PG8_SB(0, 1), b2 + hstep, voffB);
            PG8_WAIT_V(6); PG8_BAR; PG8_MMA(1, 1, At, B1); PG8_BAR;
            PG8_LDB(B0, 1, 0); PG8_SCHED; PG8_LDA(At, 1, 0); PG8_STAGE(PG8_SA(0, 1), a2 + hstep, voffA);
            PG8_WAIT_L(8); PG8_BAR; PG8_WAIT_L(0); PG8_MMA(0, 0, At, B0); PG8_BAR; PG8_SCHED;
            PG8_LDB(B1, 1, 1); PG8_STAGE(PG8_SB(1, 0), b3, voffB);
            PG8_BAR; PG8_WAIT_L(0); PG8_MMA(0, 1, At, B1); PG8_BAR;
            PG8_LDA(At, 1, 1); PG8_STAGE(PG8_SA(1, 0), a3, voffA);
            PG8_BAR; PG8_WAIT_L(0); PG8_MMA(1, 0, At, B0); PG8_BAR; PG8_SCHED;
            PG8_STAGE(PG8_SB(1, 1), b3 + hstep, voffB);
            PG8_WAIT_V(6); PG8_BAR; PG8_MMA(1, 1, At, B1); PG8_BAR;
            }
        }
        if constexpr (ALIGN_EPI) { if (wr == 0) PG8_BAR; }
        if constexpr (!Epi::AFTER_DRAIN) { E(acc, cur, wr, wc, fr, fq); S.done(cur); }
        if (!has_next) break;
#pragma unroll
        for (int a = 0; a < 2; ++a)
#pragma unroll
            for (int b = 0; b < 2; ++b)
#pragma unroll
                for (int m = 0; m < 4; ++m)
#pragma unroll
                    for (int n = 0; n < 2; ++n) acc[a][b][m][n] = (f32x4){0.f, 0.f, 0.f, 0.f};
        cur = nxt; cA = nA; cB = nB; ++ui;
        if constexpr (ALIGN_EPI) { if (wr == 1) PG8_BAR; }
    }
    PG8_WAIT_V(0);
    if constexpr (!ALIGN_EPI) { if (wr == 0) PG8_BAR; }
    PG8_BAR;
    if constexpr (Epi::AFTER_DRAIN) { E.fused(acc, cur, wr, wc, fr, fq, lds, wid, lane); S.done(cur); }
#undef PG8_SA
#undef PG8_SB
#undef PG8_STAGE
#undef PG8_LDA
#undef PG8_LDB
#undef PG8_MMA
#undef PG8_WAIT_V
#undef PG8_WAIT_L
#undef PG8_BAR
#undef PG8_SCHED
}
}

constexpr int DM = 1024, NB = 8, SEQ = 2048, NS = 128, DSEQ = 4, NIN = 3072, DFF = 4096;
constexpr int TP = NB * SEQ, TS = NS * DSEQ, T = TP + TS, NSEQ = NB + NS;
constexpr int Z_A = 0, Z_Q = 512, Z_F = 1024, Z_I = 1536, Z_G = 2048, Z_C = 2560;
constexpr int Y_A = 0, Y_B = 256, Y_C = 768;
constexpr int MODLD = 2 * 6 * DM;
constexpr float EPS = 1e-6f;
constexpr int HSEG = 128, NSEGS = SEQ / HSEG, HCH = HSEG / 16;
constexpr size_t O_Y = 0, O_HP = (size_t)T * DM, O_HS = O_HP + (size_t)2 * NB * 8 * 4096, O_CP = O_HS + (size_t)2 * NS * 8 * 4096,
                 O_CS = O_CP + (size_t)2 * NB * 30 * 256, O_GV = O_CS + (size_t)2 * NS * 30 * 256;
constexpr size_t MiB = 1u << 20;
constexpr size_t WS_AADA = 1 * MiB, WS_MOD = 2 * MiB, WS_WIN = 9 * MiB, WS_WOUT = 21 * MiB, WS_WUP = 25 * MiB, WS_WDN = 41 * MiB,
                 WS_HY = 57 * MiB, WS_Z = 90 * MiB, WS_YMIX = 189 * MiB, WS_U = 90 * MiB, WS_WADA = 90 * MiB, WS_SEGL = 222 * MiB, WS_SEGD = 238 * MiB, WS_END = 239 * MiB;
constexpr int LDS_BYTES = 147456, NWAVES = 8;

#define LAS __attribute__((address_space(3)))
typedef unsigned short bf16;
typedef float f32x4 __attribute__((ext_vector_type(4)));
typedef short s16x8 __attribute__((ext_vector_type(8)));
typedef short s16x4 __attribute__((ext_vector_type(4)));
typedef unsigned u32x2 __attribute__((ext_vector_type(2)));
typedef unsigned u32x4 __attribute__((ext_vector_type(4)));
#define LDS_FENCE() asm volatile("s_waitcnt lgkmcnt(0)" ::: "memory")

__device__ __forceinline__ float bf2f(unsigned b) { return __uint_as_float(b << 16); }
typedef float f32x2_t __attribute__((ext_vector_type(2))); typedef __bf16 bf16x2_t __attribute__((ext_vector_type(2)));
__device__ __forceinline__ unsigned pk2(float lo, float hi) { f32x2_t v = {lo, hi}; bf16x2_t b = __builtin_convertvector(v, bf16x2_t); return __builtin_bit_cast(unsigned, b); }
__device__ __forceinline__ unsigned f2bf(float f) { return pk2(f, 0.f) & 0xffffu; }
template <int CTRL> __device__ __forceinline__ float dpp_(float x) { return __builtin_bit_cast(float, __builtin_amdgcn_mov_dpp(__builtin_bit_cast(int, x), CTRL, 0xf, 0xf, true)); }
__device__ __forceinline__ float row16_sum(float v) {
    v += dpp_<0xB1>(v); v += dpp_<0x4E>(v); v += dpp_<0x141>(v); v += dpp_<0x128>(v); return v;
}
__device__ __forceinline__ float wave_sum(float v) {
    v = row16_sum(v);
    auto s = __builtin_amdgcn_permlane16_swap(__float_as_uint(v), __float_as_uint(v), false, false);
    v = __uint_as_float(s[0]) + __uint_as_float(s[1]);
    auto t = __builtin_amdgcn_permlane32_swap(__float_as_uint(v), __float_as_uint(v), false, false);
    return __uint_as_float(t[0]) + __uint_as_float(t[1]);
}
__device__ __forceinline__ float frcp(float x) { return __builtin_amdgcn_rcpf(x); }
__device__ __forceinline__ float sigmoidf_(float x) { return frcp(1.f + __expf(-x)); }
__device__ __forceinline__ float siluf_(float x) { return x * sigmoidf_(x); }
__device__ __forceinline__ float geluf_(float v) {
    const float t = frcp(fabsf(v) * 0.2316418882f + 1.0f);
    float q = t * 0.5307027145f + (-0.7265760135f); q = q * t + 0.7107068705f; q = q * t + (-0.142248368f); q = q * t + 0.127414796f; q = q * t;
    const float e = __builtin_amdgcn_exp2f(v * v * (-0.72134752044f));
    const float m = v * (q * e);
    return v < 0.f ? m : v - m;
}
__device__ __forceinline__ void unpack4(u32x2 r, float (&v)[4]) { v[0] = bf2f(r.x & 0xffffu); v[1] = bf2f(r.x >> 16); v[2] = bf2f(r.y & 0xffffu); v[3] = bf2f(r.y >> 16); }

struct Args { const float* in[26]; float* out; unsigned char* ws; };
enum { I_XP = 0, I_XS, I_SH, I_SC, I_CP, I_CS, I_WADA, I_BADA, I_GPRE1, I_GPOST1, I_GPRE2, I_GPOST2, I_WIN, I_ALNG, I_ALNB, I_AWS, I_ABS, I_BLB, I_BGN,
       I_CW, I_CB, I_CLNG, I_CLNB, I_WOUT, I_WUP, I_WDN };

__device__ __forceinline__ int seq_of_row(int r) { return r < TP ? (r >> 11) : NB + ((r - TP) >> 2); }

__device__ __forceinline__ void p0_transpose_item(const float* W, int K, int N, bf16* WT, int item, int lane) {
    const int nblk = N / 64, kb = item / nblk, nb = item % nblk, k0 = 64 * kb, n = 64 * nb + lane;
    const float* src = W + (size_t)k0 * N + n;
    float v[64];
#pragma unroll
    for (int i = 0; i < 64; ++i) v[i] = __builtin_nontemporal_load(src + (size_t)i * N);
    bf16* dst = WT + (size_t)n * K + k0;
#pragma unroll
    for (int g = 0; g < 8; ++g) { u32x4 o; o.x = pk2(v[8 * g], v[8 * g + 1]); o.y = pk2(v[8 * g + 2], v[8 * g + 3]); o.z = pk2(v[8 * g + 4], v[8 * g + 5]); o.w = pk2(v[8 * g + 6], v[8 * g + 7]);
        *(u32x4*)(dst + 8 * g) = o; }
}
constexpr int I_IN = 16 * 48, I_OUT = 16 * 16, I_UP = 16 * 64, I_DN = 64 * 16, I_ADA = 16 * 96;
constexpr int N_LATE0 = I_OUT + I_UP + I_DN, N_LATE1 = I_IN + I_OUT + I_UP + I_DN;
__device__ __forceinline__ void late_item(const Args& a, int lyr, int r, int lane) {
    unsigned char* ws = a.ws; const int l = lyr;
    if (lyr == 1) { if (r < I_IN) { p0_transpose_item(a.in[I_WIN] + (size_t)l * DM * NIN, DM, NIN, (bf16*)(ws + WS_WIN) + (size_t)l * NIN * DM, r, lane); return; } r -= I_IN; }
    if (r < I_OUT) { p0_transpose_item(a.in[I_WOUT] + (size_t)l * DM * DM, DM, DM, (bf16*)(ws + WS_WOUT) + (size_t)l * DM * DM, r, lane); return; } r -= I_OUT;
    if (r < I_UP) { p0_transpose_item(a.in[I_WUP] + (size_t)l * DM * DFF, DM, DFF, (bf16*)(ws + WS_WUP) + (size_t)l * DFF * DM, r, lane); return; } r -= I_UP;
    p0_transpose_item(a.in[I_WDN] + (size_t)l * DFF * DM, DFF, DM, (bf16*)(ws + WS_WDN) + (size_t)l * DM * DFF, r, lane);
}
__device__ __forceinline__ void p0_prologue(const Args& a, LAS unsigned char* lds, int gw, int NGW, int wave, int lane) {
    for (int it = gw; it < I_IN; it += NGW) p0_transpose_item(a.in[I_WIN], DM, NIN, (bf16*)(a.ws + WS_WIN), it, lane);
}

__device__ __forceinline__ const float* modp(const Args& a, int seq, int l, int part) { return (const float*)(a.ws + WS_MOD) + (size_t)seq * MODLD + (l * 6 + part) * DM; }
__device__ __forceinline__ void modulate_store(const f32x4 (&x)[4], const float* g, const float* sc, const float* sh, bf16* hrow, int lane) {
    float ss = 0.f;
#pragma unroll
    for (int j = 0; j < 4; ++j) ss += (x[j][0] * x[j][0] + x[j][1] * x[j][1]) + (x[j][2] * x[j][2] + x[j][3] * x[j][3]);
    const float rstd = rsqrtf(wave_sum(ss) * (1.f / DM) + EPS);
#pragma unroll
    for (int j = 0; j < 4; ++j) { const f32x4 gv = ((const f32x4*)g)[lane + 64 * j], sv = ((const f32x4*)sc)[lane + 64 * j], hv = ((const f32x4*)sh)[lane + 64 * j];
        const f32x4 h = x[j] * rstd * gv * (sv + 1.f) + hv; u32x2 w; w.x = pk2(h[0], h[1]); w.y = pk2(h[2], h[3]); ((u32x2*)hrow)[lane + 64 * j] = w; }
}
template <int MODE, int NR>
__device__ __forceinline__ void norm_rows(const float* xin, float* xout, bf16* hy, const float* gate, const float* gpost, const float* gnext, const float* sc, const float* sh, int lane) {
    f32x4 cA[4], cB[4], cC[4];
#pragma unroll
    for (int j = 0; j < 4; ++j) {
        if (MODE != 0) cA[j] = ((const f32x4*)gate)[lane + 64 * j] * ((const f32x4*)gpost)[lane + 64 * j];
        if (MODE != 2) { cB[j] = ((const f32x4*)gnext)[lane + 64 * j] * (((const f32x4*)sc)[lane + 64 * j] + 1.f); cC[j] = ((const f32x4*)sh)[lane + 64 * j]; } }
    f32x4 xb[3][4]; u32x2 yb[3][4];
#define NR_LOAD(slot, r) do { _Pragma("unroll") for (int j = 0; j < 4; ++j) { xb[slot][j] = __builtin_nontemporal_load((const f32x4*)(xin + (size_t)(r) * DM) + lane + 64 * j); \
        if (MODE != 0) yb[slot][j] = __builtin_nontemporal_load((const u32x2*)(hy + (size_t)(r) * DM) + lane + 64 * j); } } while (0)
    NR_LOAD(0, 0);
    if (NR > 1) NR_LOAD(1, 1);
#pragma unroll
    for (int i = 0; i < NR; ++i) {
        if (i + 2 < NR) NR_LOAD((i + 2) % 3, i + 2);
        f32x4 (&x)[4] = xb[i % 3]; u32x2 (&yr)[4] = yb[i % 3];
        if (MODE != 0) {
            f32x4 y[4]; float ss = 0.f;
#pragma unroll
            for (int j = 0; j < 4; ++j) { float t[4]; unpack4(yr[j], t); y[j] = (f32x4){t[0], t[1], t[2], t[3]}; ss += (t[0] * t[0] + t[1] * t[1]) + (t[2] * t[2] + t[3] * t[3]); }
            const float rstd = rsqrtf(wave_sum(ss) * (1.f / DM) + EPS);
#pragma unroll
            for (int j = 0; j < 4; ++j) { x[j] = x[j] + cA[j] * (y[j] * rstd); __builtin_nontemporal_store(x[j], (f32x4*)(xout + (size_t)i * DM) + lane + 64 * j); }
        }
        if (MODE != 2) {
            float ss = 0.f;
#pragma unroll
            for (int j = 0; j < 4; ++j) ss += (x[j][0] * x[j][0] + x[j][1] * x[j][1]) + (x[j][2] * x[j][2] + x[j][3] * x[j][3]);
            const float rstd = rsqrtf(wave_sum(ss) * (1.f / DM) + EPS);
#pragma unroll
            for (int j = 0; j < 4; ++j) { const f32x4 h = x[j] * rstd * cB[j] + cC[j]; u32x2 w; w.x = pk2(h[0], h[1]); w.y = pk2(h[2], h[3]); ((u32x2*)(hy + (size_t)i * DM))[lane + 64 * j] = w; }
        }
    }
#undef NR_LOAD
}
__device__ __forceinline__ void prenorm0_phase(const Args& a, int gw, int NGW, int lane) {
    bf16* HY = (bf16*)(a.ws + WS_HY);
    for (int r0 = gw * 8; r0 < TP; r0 += NGW * 8) { const int s = r0 >> 11;
        norm_rows<0, 8>(a.in[I_XP] + (size_t)r0 * DM, nullptr, HY + (size_t)r0 * DM, nullptr, nullptr, a.in[I_GPRE1], modp(a, s, 0, 1), modp(a, s, 0, 0), lane); }
    for (int q = NGW - 1 - gw; q < TS; q += NGW) { const int s = NB + (q >> 2);
        norm_rows<0, 1>(a.in[I_XS] + (size_t)q * DM, nullptr, HY + (size_t)(TP + q) * DM, nullptr, nullptr, a.in[I_GPRE1], modp(a, s, 0, 1), modp(a, s, 0, 0), lane); }
}
template <int L, int WHICH>
__device__ __forceinline__ void postnorm_phase(const Args& a, int gw, int NGW, int lane) {
    constexpr int l = L, which = WHICH;
    bf16* HY = (bf16*)(a.ws + WS_HY);
    const float* gpost = a.in[which == 0 ? I_GPOST1 : I_GPOST2] + (size_t)l * DM;
    constexpr bool from_input = (l == 0 && which == 0);
    constexpr bool has_next = (which == 0) || (l + 1 < 2);
    constexpr int nl = which == 0 ? l : (l + 1 < 2 ? l + 1 : l);
    constexpr int MODE = has_next ? 1 : 2;
    const float* gnext = a.in[which == 0 ? I_GPRE2 : I_GPRE1] + (size_t)nl * DM;
    for (int r0 = gw * 8; r0 < TP; r0 += NGW * 8) { const int s = r0 >> 11;
        const float* xin = from_input ? a.in[I_XP] + (size_t)r0 * DM : a.out + (size_t)r0 * DM;
        norm_rows<MODE, 8>(xin, a.out + (size_t)r0 * DM, HY + (size_t)r0 * DM, modp(a, s, l, which == 0 ? 2 : 5), gpost, gnext, modp(a, s, nl, which == 0 ? 4 : 1), modp(a, s, nl, which == 0 ? 3 : 0), lane); }
    for (int q = NGW - 1 - gw; q < TS; q += NGW) { const int s = NB + (q >> 2); const int r = TP + q;
        const float* xin = from_input ? a.in[I_XS] + (size_t)q * DM : a.out + (size_t)r * DM;
        norm_rows<MODE, 1>(xin, a.out + (size_t)r * DM, HY + (size_t)r * DM, modp(a, s, l, which == 0 ? 2 : 5), gpost, gnext, modp(a, s, nl, which == 0 ? 4 : 1), modp(a, s, nl, which == 0 ? 3 : 0), lane); }
}

constexpr int VT_LD = 136;
template <int HALF> __device__ __forceinline__ void gmlp_chunk(const Args& a, int l, int chunk, LAS unsigned char* lds, int wave, int lane) {
    constexpr int NR = HALF ? 16 : 12, TT0 = HALF ? 6 : 0, TT1 = HALF ? 8 : 6;
    const bf16* Z = (const bf16*)(a.ws + WS_Z); bf16* Y = (bf16*)(a.ws + WS_YMIX);
    LAS bf16* vT = (LAS bf16*)lds;
    const int r0 = chunk * 128, fr = lane & 15, fq = lane >> 4;
    const f32x4 lg = ((const f32x4*)(a.in[I_ALNG] + l * 256))[lane], lb = ((const f32x4*)(a.in[I_ALNB] + l * 256))[lane];
    u32x2 rawv[NR];
#pragma unroll
    for (int i = 0; i < NR; ++i) rawv[i] = __builtin_nontemporal_load((const u32x2*)(Z + (size_t)(r0 + wave + 8 * i) * NIN + Z_A + 256 + 4 * lane));
#pragma unroll 4
    for (int i = 0; i < NR; ++i) { const int s = wave + 8 * i;
        float g[4]; unpack4(rawv[i], g);
#pragma unroll
        for (int e = 0; e < 4; ++e) g[e] = geluf_(g[e]);
        const float mean = wave_sum((g[0] + g[1]) + (g[2] + g[3])) * (1.f / 256.f);
#pragma unroll
        for (int e = 0; e < 4; ++e) g[e] -= mean;
        const float rstd = rsqrtf(wave_sum((g[0] * g[0] + g[1] * g[1]) + (g[2] * g[2] + g[3] * g[3])) * (1.f / 256.f) + EPS);
#pragma unroll
        for (int e = 0; e < 4; ++e) vT[(4 * lane + e) * VT_LD + s] = (bf16)f2bf(g[e] * rstd * lg[e] + lb[e]);
    }
    __syncthreads();
    const int h = wave >> 1, dtp = wave & 1;
    const float* W = a.in[I_AWS] + ((size_t)l * 4 + h) * 128 * 128; const float* bs = a.in[I_ABS] + (l * 4 + h) * 128;
#pragma unroll
    for (int tt = TT0; tt < TT1; ++tt) {
        f32x4 acc0 = {0.f, 0.f, 0.f, 0.f}, acc1 = {0.f, 0.f, 0.f, 0.f};
        const int t = 16 * tt + fr;
        constexpr int NK = 4;
        f32x4 w0[NK], w1[NK];
#pragma unroll
        for (int ks = 0; ks < NK; ++ks) if (ks <= (tt >> 1)) { const int s0 = 32 * ks + 8 * fq; w0[ks] = *(const f32x4*)(W + t * 128 + s0); w1[ks] = *(const f32x4*)(W + t * 128 + s0 + 4); }
        const float bias = bs[t];
        u32x2 rawu[2];
#pragma unroll
        for (int i = 0; i < 2; ++i) rawu[i] = __builtin_nontemporal_load((const u32x2*)(Z + (size_t)(r0 + t) * NIN + Z_A + h * 64 + (2 * dtp + i) * 16 + 4 * fq));
#pragma unroll
        for (int ks = 0; ks < NK; ++ks) if (ks <= (tt >> 1)) {
            const int s0 = 32 * ks + 8 * fq;
#pragma unroll
            for (int e = 0; e < 4; ++e) { if (s0 + e > t) w0[ks][e] = 0.f; if (s0 + 4 + e > t) w1[ks][e] = 0.f; }
            u32x4 bw; bw.x = pk2(w0[ks][0], w0[ks][1]); bw.y = pk2(w0[ks][2], w0[ks][3]); bw.z = pk2(w1[ks][0], w1[ks][1]); bw.w = pk2(w1[ks][2], w1[ks][3]);
            const s16x8 B = __builtin_bit_cast(s16x8, bw);
            const s16x8 A0 = *(const LAS s16x8*)(vT + (h * 64 + (2 * dtp) * 16 + fr) * VT_LD + s0);
            const s16x8 A1 = *(const LAS s16x8*)(vT + (h * 64 + (2 * dtp + 1) * 16 + fr) * VT_LD + s0);
            acc0 = __builtin_amdgcn_mfma_f32_16x16x32_bf16(A0, B, acc0, 0, 0, 0);
            acc1 = __builtin_amdgcn_mfma_f32_16x16x32_bf16(A1, B, acc1, 0, 0, 0);
        }
#pragma unroll
        for (int i = 0; i < 2; ++i) { const int col = h * 64 + (2 * dtp + i) * 16 + 4 * fq; const f32x4 m = i == 0 ? acc0 : acc1;
            float u[4]; unpack4(rawu[i], u);
            float o[4];
#pragma unroll
            for (int e = 0; e < 4; ++e) o[e] = geluf_(u[e]) * (m[e] + bias);
            u32x2 w; w.x = pk2(o[0], o[1]); w.y = pk2(o[2], o[3]); *(u32x2*)(Y + (size_t)(r0 + t) * DM + Y_A + col) = w; }
    }
    __syncthreads();
}
__device__ __forceinline__ void gmlp_sample(const Args& a, int l, int n, int lane) {
    const bf16* Z = (const bf16*)(a.ws + WS_Z); bf16* Y = (bf16*)(a.ws + WS_YMIX);
    const f32x4 lg = ((const f32x4*)(a.in[I_ALNG] + l * 256))[lane], lb = ((const f32x4*)(a.in[I_ALNB] + l * 256))[lane];
    const int h = lane >> 4; const float* W = a.in[I_AWS] + ((size_t)l * 4 + h) * 128 * 128; const float* bs = a.in[I_ABS] + (l * 4 + h) * 128;
    float v[4][4];
#pragma unroll
    for (int t = 0; t < 4; ++t) { const int r = TP + 4 * n + t;
        const u32x2 raw = *(const u32x2*)(Z + (size_t)r * NIN + Z_A + 256 + 4 * lane); float g[4]; unpack4(raw, g);
#pragma unroll
        for (int i = 0; i < 4; ++i) g[i] = geluf_(g[i]);
        const float mean = wave_sum((g[0] + g[1]) + (g[2] + g[3])) * (1.f / 256.f);
#pragma unroll
        for (int i = 0; i < 4; ++i) g[i] -= mean;
        const float rstd = rsqrtf(wave_sum((g[0] * g[0] + g[1] * g[1]) + (g[2] * g[2] + g[3] * g[3])) * (1.f / 256.f) + EPS);
#pragma unroll
        for (int i = 0; i < 4; ++i) v[t][i] = g[i] * rstd * lg[i] + lb[i];
        *(f32x4*)(a.out + O_GV + ((size_t)(l * NS + n) * 4 + t) * 256 + 4 * lane) = (f32x4){v[t][0], v[t][1], v[t][2], v[t][3]};
    }
#pragma unroll
    for (int t = 0; t < 4; ++t) { const int r = TP + 4 * n + t; const float bias = bs[t];
        const u32x2 raw = *(const u32x2*)(Z + (size_t)r * NIN + Z_A + 4 * lane); float u[4]; unpack4(raw, u); float o[4];
#pragma unroll
        for (int i = 0; i < 4; ++i) { float m = bias;
#pragma unroll
            for (int s = 0; s <= t; ++s) m += W[t * 128 + s] * v[s][i];
            o[i] = geluf_(u[i]) * m; }
        u32x2 w; w.x = pk2(o[0], o[1]); w.y = pk2(o[2], o[3]); *(u32x2*)(Y + (size_t)r * DM + Y_A + 4 * lane) = w; }
}

__device__ __forceinline__ void conv_item(const Args& a, int l, int seq, int t0, int nt, LAS unsigned char* lds, int tid, int wave, int lane) {
    const bf16* Z = (const bf16*)(a.ws + WS_Z); bf16* Y = (bf16*)(a.ws + WS_YMIX);
    LAS float* xs = (LAS float*)lds;
    const bool samp = seq >= NB; const int n = seq - NB; const int rowbase = samp ? TP + 4 * n : seq * SEQ;
    if (!samp) {
        u32x2 ra[12], rg[12];
#pragma unroll
        for (int i = 0; i < 12; ++i) { const int p = wave + 8 * i; int t = t0 - 30 + p; t = t < 0 ? 0 : t; const int pp = p < 94 ? t : t0;
            const bf16* zr = Z + (size_t)(rowbase + pp) * NIN + Z_C + 4 * lane; ra[i] = __builtin_nontemporal_load((const u32x2*)zr); rg[i] = __builtin_nontemporal_load((const u32x2*)(zr + 256)); }
#pragma unroll
        for (int i = 0; i < 12; ++i) { const int p = wave + 8 * i; const int t = t0 - 30 + p;
            if (p < 94) { float av[4], gv[4]; unpack4(ra[i], av); unpack4(rg[i], gv); f32x4 xg;
#pragma unroll
                for (int e = 0; e < 4; ++e) xg[e] = t >= 0 ? av[e] * sigmoidf_(gv[e]) : 0.f;
                *(LAS f32x4*)(xs + p * 256 + 4 * lane) = xg;
                if (t >= SEQ - 30) __builtin_nontemporal_store(xg, (f32x4*)(a.out + O_CP + ((size_t)(l * NB + seq) * 30 + (t - (SEQ - 30))) * 256 + 4 * lane)); } }
    } else {
        for (int p = wave; p < nt + 30; p += 8) {
            const int t = t0 - 30 + p; f32x4 xg = {0.f, 0.f, 0.f, 0.f};
            if (t >= 0) { const bf16* zr = Z + (size_t)(rowbase + t) * NIN + Z_C + 4 * lane; float av[4], gv[4]; unpack4(*(const u32x2*)zr, av); unpack4(*(const u32x2*)(zr + 256), gv);
#pragma unroll
                for (int e = 0; e < 4; ++e) xg[e] = av[e] * sigmoidf_(gv[e]); }
            else xg = *(const f32x4*)(a.in[I_SC] + ((size_t)(l * NS + n) * 30 + (30 + t)) * 256 + 4 * lane);
            *(LAS f32x4*)(xs + p * 256 + 4 * lane) = xg;
            if (p >= 4) __builtin_nontemporal_store(xg, (f32x4*)(a.out + O_CS + ((size_t)(l * NS + n) * 30 + (p - 4)) * 256 + 4 * lane));
        }
    }
    __syncthreads();
    const int c = tid & 255, tb = 32 * (tid >> 8);
    float y[32];
    if (tb < nt) {
        float w[31]; const float* wd = a.in[I_CW] + (size_t)l * 31 * 256 + c;
#pragma unroll
        for (int j = 0; j < 31; ++j) w[j] = wd[j * 256];
        const float bias = a.in[I_CB][l * 256 + c];
#pragma unroll
        for (int i = 0; i < 32; ++i) y[i] = bias;
#pragma unroll
        for (int p = 0; p < 62; ++p) { const float x = xs[(tb + p) * 256 + c];
#pragma unroll
            for (int i = (p > 30 ? p - 30 : 0); i <= (p < 31 ? p : 31); ++i) y[i] += w[p - i] * x; }
    }
    __syncthreads();
    if (tb < nt) {
#pragma unroll
        for (int i = 0; i < 32; ++i) xs[(tb + i) * 256 + c] = y[i];
    }
    __syncthreads();
    const f32x4 lg = ((const f32x4*)(a.in[I_CLNG] + l * 256))[lane], lb = ((const f32x4*)(a.in[I_CLNB] + l * 256))[lane];
    for (int tk = wave; tk < nt; tk += 8) {
        f32x4 v = *(const LAS f32x4*)(xs + tk * 256 + 4 * lane);
        const float mean = wave_sum((v[0] + v[1]) + (v[2] + v[3])) * (1.f / 256.f);
        v = v - mean;
        const float rstd = rsqrtf(wave_sum((v[0] * v[0] + v[1] * v[1]) + (v[2] * v[2] + v[3] * v[3])) * (1.f / 256.f) + EPS);
        float o[4];
#pragma unroll
        for (int e = 0; e < 4; ++e) o[e] = siluf_(v[e] * rstd * lg[e] + lb[e]);
        u32x2 w; w.x = pk2(o[0], o[1]); w.y = pk2(o[2], o[3]); *(u32x2*)(Y + (size_t)(rowbase + t0 + tk) * DM + Y_C + 4 * lane) = w;
    }
    __syncthreads();
}

template <bool WITH_O>
__device__ __forceinline__ void hgrn_run(const bf16* Z, bf16* Y, int row0, int nchunk, int ntok, int h, float lbk, const float* gn, f32x4 (&S)[4][4], float& btot, LAS unsigned char* wl, int lane) {
    LAS bf16* Q = (LAS bf16*)wl; LAS bf16* Kt = (LAS bf16*)(wl + 2048); LAS bf16* KT = (LAS bf16*)(wl + 4096); LAS float* Dv = (LAS float*)(wl + 6144);
    const float omlb = 1.f - lbk;
    const bf16* zb = Z + (size_t)row0 * NIN + h * 64;
    bf16* yb = WITH_O ? Y + (size_t)row0 * DM + Y_B + h * 64 : nullptr;
    for (int c = 0; c < nchunk; ++c, zb += 16 * NIN, yb += 16 * DM) {
        unsigned la = (unsigned)lane; asm volatile("" : "+v"(la));
        const unsigned fr = la & 15u, fq = la >> 4;
        const int nv = ntok - c * 16;
        float b = 0.f; unsigned kpk[8];
#pragma unroll
        for (int t = 0; t < 16; ++t) {
            float q = 0.f, kk = 0.f, lf = 0.f;
            if (t < nv) { const bf16* zr = zb + t * NIN;
                const float zq = bf2f(zr[la + Z_Q]), zf = bf2f(zr[la + Z_F]);
                const float e = __expf(-zf), sg = frcp(1.f + e);
                const float f = lbk + omlb * sg; lf = __logf(f); kk = omlb * (e * sg); q = siluf_(zq) * 0.125f; }
            b += lf; const float eb = __expf(b); const float qin = q * eb, kin = kk * frcp(eb);
            const unsigned kb = f2bf(kin);
            if (WITH_O) { Q[t * 64 + la] = (bf16)f2bf(qin); Kt[t * 64 + la] = (bf16)kb; }
            if (t & 1) kpk[t >> 1] |= kb << 16; else kpk[t >> 1] = kb;
        }
        *(LAS u32x4*)(KT + la * 16) = (u32x4){kpk[0], kpk[1], kpk[2], kpk[3]}; *(LAS u32x4*)(KT + la * 16 + 8) = (u32x4){kpk[4], kpk[5], kpk[6], kpk[7]};
        Dv[la] = __expf(b); btot += b;
        LDS_FENCE();
        s16x4 vB[4];
#pragma unroll
        for (int vt = 0; vt < 4; ++vt) { unsigned e[4];
#pragma unroll
            for (int j = 0; j < 4; ++j) { const unsigned tok = 4 * fq + j; e[j] = (int)tok < nv ? (unsigned)zb[tok * NIN + Z_I + 16 * vt + fr] : 0u; }
            vB[vt] = __builtin_bit_cast(s16x4, (u32x2){e[0] | (e[1] << 16), e[2] | (e[3] << 16)}); }
        f32x4 Dk[4];
#pragma unroll
        for (int kt = 0; kt < 4; ++kt) Dk[kt] = *(const LAS f32x4*)(Dv + 16 * kt + 4 * fq);
        f32x4 o[4];
        if (WITH_O) {
            s16x4 qa[4], ka[4];
#pragma unroll
            for (int kt = 0; kt < 4; ++kt) { qa[kt] = *(const LAS s16x4*)(Q + fr * 64 + 16 * kt + 4 * fq); ka[kt] = *(const LAS s16x4*)(Kt + fr * 64 + 16 * kt + 4 * fq); }
            f32x4 sT = {0.f, 0.f, 0.f, 0.f};
#pragma unroll
            for (int kt = 0; kt < 4; ++kt) sT = __builtin_amdgcn_mfma_f32_16x16x16bf16_1k(ka[kt], qa[kt], sT, 0, 0, 0);
#pragma unroll
            for (int j = 0; j < 4; ++j) if (4 * fq + j > fr) sT[j] = 0.f;
            const s16x4 P = __builtin_bit_cast(s16x4, (u32x2){pk2(sT[0], sT[1]), pk2(sT[2], sT[3])});
#pragma unroll
            for (int vt = 0; vt < 4; ++vt) { f32x4 acc = {0.f, 0.f, 0.f, 0.f};
                acc = __builtin_amdgcn_mfma_f32_16x16x16bf16_1k(P, vB[vt], acc, 0, 0, 0);
#pragma unroll
                for (int kt = 0; kt < 4; ++kt) { const s16x4 Sb = __builtin_bit_cast(s16x4, (u32x2){pk2(S[kt][vt][0], S[kt][vt][1]), pk2(S[kt][vt][2], S[kt][vt][3])});
                    acc = __builtin_amdgcn_mfma_f32_16x16x16bf16_1k(qa[kt], Sb, acc, 0, 0, 0); }
                o[vt] = acc; }
        }
#pragma unroll
        for (int kt = 0; kt < 4; ++kt) { const s16x4 KTa = *(const LAS s16x4*)(KT + (16 * kt + fr) * 16 + 4 * fq);
#pragma unroll
            for (int vt = 0; vt < 4; ++vt) { S[kt][vt] = __builtin_amdgcn_mfma_f32_16x16x16bf16_1k(KTa, vB[vt], S[kt][vt], 0, 0, 0); S[kt][vt] = S[kt][vt] * Dk[kt]; } }
        if (WITH_O) {
            float gnv[4];
#pragma unroll
            for (int vt = 0; vt < 4; ++vt) gnv[vt] = gn[16 * vt + fr];
#pragma unroll
            for (int j = 0; j < 4; ++j) { float ss = (o[0][j] * o[0][j] + o[1][j] * o[1][j]) + (o[2][j] * o[2][j] + o[3][j] * o[3][j]);
                ss = row16_sum(ss);
                const float rstd = rsqrtf(ss * (1.f / 64.f) + EPS);
                const unsigned tok = 4 * fq + j;
                if ((int)tok < nv) {
#pragma unroll
                    for (int vt = 0; vt < 4; ++vt) { const float zg = bf2f(zb[tok * NIN + Z_G + 16 * vt + fr]);
                        yb[tok * DM + 16 * vt + fr] = (bf16)f2bf(o[vt][j] * rstd * gnv[vt] * siluf_(zg)); } } }
        }
        LDS_FENCE();
    }
}
template <bool WITH_O>
__device__ __forceinline__ void hgrn_full(const bf16* Z, bf16* Y, int row0, int nchunk, int h, float lbk, const float* gn, f32x4 (&S)[4][4], float& dtot, LAS unsigned char* wl, int lane) {
    LAS bf16* Q = (LAS bf16*)wl; LAS bf16* Kt = (LAS bf16*)(wl + 2048); LAS bf16* KT = (LAS bf16*)(wl + 4096); LAS float* Dv = (LAS float*)(wl + 6144);
    const float omlb = 1.f - lbk;
    const bf16* zb = Z + (size_t)row0 * NIN + h * 64;
    bf16* yb = WITH_O ? Y + (size_t)row0 * DM + Y_B + h * 64 : nullptr;
    unsigned rq[16], rf[16];
    {   unsigned la = (unsigned)lane; asm volatile("" : "+v"(la));
#pragma unroll
        for (int t = 0; t < 16; ++t) { rf[t] = WITH_O ? __builtin_nontemporal_load(zb + t * NIN + la + Z_F) : zb[t * NIN + la + Z_F]; if (WITH_O) rq[t] = __builtin_nontemporal_load(zb + t * NIN + la + Z_Q); } }
    for (int c = 0; c < nchunk; ++c, zb += 16 * NIN, yb += 16 * DM) {
        unsigned la = (unsigned)lane; asm volatile("" : "+v"(la));
        const unsigned fr = la & 15u, fq = la >> 4;
        unsigned rv[16], rg[16];
#pragma unroll
        for (int vt = 0; vt < 4; ++vt)
#pragma unroll
            for (int j = 0; j < 4; ++j) { rv[vt * 4 + j] = WITH_O ? __builtin_nontemporal_load(zb + (4 * fq + j) * NIN + Z_I + 16 * vt + fr) : zb[(4 * fq + j) * NIN + Z_I + 16 * vt + fr]; if (WITH_O) rg[vt * 4 + j] = __builtin_nontemporal_load(zb + (4 * fq + j) * NIN + Z_G + 16 * vt + fr); }
        float P = 1.f; unsigned kpk[8];
#pragma unroll
        for (int t = 0; t < 16; ++t) {
            const float zf = bf2f(rf[t]);
            const float e = __expf(-zf), sg = frcp(1.f + e);
            const float f = lbk + omlb * sg, kk = omlb * (e * sg);
            P *= f; const float kin = kk * frcp(P);
            const unsigned kb = f2bf(kin);
            if (WITH_O) { const float zq = bf2f(rq[t]); const float qin = zq * frcp(1.f + __expf(-zq)) * 0.125f * P; Q[t * 64 + la] = (bf16)f2bf(qin); Kt[t * 64 + la] = (bf16)kb; }
            if (t & 1) kpk[t >> 1] |= kb << 16; else kpk[t >> 1] = kb;
        }
        *(LAS u32x4*)(KT + la * 16) = (u32x4){kpk[0], kpk[1], kpk[2], kpk[3]}; *(LAS u32x4*)(KT + la * 16 + 8) = (u32x4){kpk[4], kpk[5], kpk[6], kpk[7]};
        Dv[la] = P; dtot *= P;
        if (c + 1 < nchunk) {
            const bf16* zn = zb + 16 * NIN;
#pragma unroll
            for (int t = 0; t < 16; ++t) { rf[t] = WITH_O ? __builtin_nontemporal_load(zn + t * NIN + la + Z_F) : zn[t * NIN + la + Z_F]; if (WITH_O) rq[t] = __builtin_nontemporal_load(zn + t * NIN + la + Z_Q); } }
        LDS_FENCE();
        s16x4 vB[4];
#pragma unroll
        for (int vt = 0; vt < 4; ++vt) vB[vt] = __builtin_bit_cast(s16x4, (u32x2){rv[vt * 4] | (rv[vt * 4 + 1] << 16), rv[vt * 4 + 2] | (rv[vt * 4 + 3] << 16)});
        f32x4 Dk[4];
#pragma unroll
        for (int kt = 0; kt < 4; ++kt) Dk[kt] = *(const LAS f32x4*)(Dv + 16 * kt + 4 * fq);
        f32x4 o[4];
        if (WITH_O) {
            s16x4 qa[4], ka[4];
#pragma unroll
            for (int kt = 0; kt < 4; ++kt) { qa[kt] = *(const LAS s16x4*)(Q + fr * 64 + 16 * kt + 4 * fq); ka[kt] = *(const LAS s16x4*)(Kt + fr * 64 + 16 * kt + 4 * fq); }
            f32x4 sT = {0.f, 0.f, 0.f, 0.f};
#pragma unroll
            for (int kt = 0; kt < 4; ++kt) sT = __builtin_amdgcn_mfma_f32_16x16x16bf16_1k(ka[kt], qa[kt], sT, 0, 0, 0);
#pragma unroll
            for (int j = 0; j < 4; ++j) if (4 * fq + j > fr) sT[j] = 0.f;
            const s16x4 Pm = __builtin_bit_cast(s16x4, (u32x2){pk2(sT[0], sT[1]), pk2(sT[2], sT[3])});
#pragma unroll
            for (int vt = 0; vt < 4; ++vt) { f32x4 acc = {0.f, 0.f, 0.f, 0.f};
                acc = __builtin_amdgcn_mfma_f32_16x16x16bf16_1k(Pm, vB[vt], acc, 0, 0, 0);
#pragma unroll
                for (int kt = 0; kt < 4; ++kt) { const s16x4 Sb = __builtin_bit_cast(s16x4, (u32x2){pk2(S[kt][vt][0], S[kt][vt][1]), pk2(S[kt][vt][2], S[kt][vt][3])});
                    acc = __builtin_amdgcn_mfma_f32_16x16x16bf16_1k(qa[kt], Sb, acc, 0, 0, 0); }
                o[vt] = acc; }
        }
#pragma unroll
        for (int kt = 0; kt < 4; ++kt) { const s16x4 KTa = *(const LAS s16x4*)(KT + (16 * kt + fr) * 16 + 4 * fq);
#pragma unroll
            for (int vt = 0; vt < 4; ++vt) { S[kt][vt] = __builtin_amdgcn_mfma_f32_16x16x16bf16_1k(KTa, vB[vt], S[kt][vt], 0, 0, 0); S[kt][vt] = S[kt][vt] * Dk[kt]; } }
        if (WITH_O) {
            float gnv[4];
#pragma unroll
            for (int vt = 0; vt < 4; ++vt) gnv[vt] = gn[16 * vt + fr];
#pragma unroll
            for (int j = 0; j < 4; ++j) { float ss = (o[0][j] * o[0][j] + o[1][j] * o[1][j]) + (o[2][j] * o[2][j] + o[3][j] * o[3][j]);
                ss = row16_sum(ss);
                const float rstd = rsqrtf(ss * (1.f / 64.f) + EPS);
#pragma unroll
                for (int vt = 0; vt < 4; ++vt) { const float zg = bf2f(rg[vt * 4 + j]);
                    yb[(4 * fq + j) * DM + 16 * vt + fr] = (bf16)f2bf(o[vt][j] * rstd * gnv[vt] * zg * frcp(1.f + __expf(-zg))); } }
        }
        LDS_FENCE();
    }
}
__device__ __forceinline__ float hgrn_lb(const Args& a, int l, int h, int lane) {
    if (l == 0) return 0.f;
    const float* b = a.in[I_BLB]; return sigmoidf_(b[512 + h * 64 + lane] - b[h * 64 + lane]);
}
__device__ __forceinline__ void zeroS(f32x4 (&S)[4][4]) {
#pragma unroll
    for (int kt = 0; kt < 4; ++kt)
#pragma unroll
        for (int vt = 0; vt < 4; ++vt) S[kt][vt] = (f32x4){0.f, 0.f, 0.f, 0.f};
}
__device__ __forceinline__ void storeS_kv(const f32x4 (&S)[4][4], float* dst, int lane) {
    const int fr = lane & 15, fq = lane >> 4;
#pragma unroll
    for (int kt = 0; kt < 4; ++kt)
#pragma unroll
        for (int vt = 0; vt < 4; ++vt)
#pragma unroll
            for (int j = 0; j < 4; ++j) __builtin_nontemporal_store(S[kt][vt][j], dst + (16 * kt + 4 * fq + j) * 64 + 16 * vt + fr);
}
__device__ __forceinline__ void hgrn_pass1(const Args& a, int l, int unit, LAS unsigned char* wl, int lane) {
    const int j = unit % NSEGS, bh = unit / NSEGS, h = bh & 7, b = bh >> 3;
    f32x4 S[4][4]; zeroS(S); float btot = 1.f;
    hgrn_full<false>((const bf16*)(a.ws + WS_Z), nullptr, b * SEQ + j * HSEG, HCH, h, hgrn_lb(a, l, h, lane), nullptr, S, btot, wl, lane);
    u32x2* L = (u32x2*)(a.ws + WS_SEGL) + (size_t)unit * 1024;
#pragma unroll
    for (int kt = 0; kt < 4; ++kt)
#pragma unroll
        for (int vt = 0; vt < 4; ++vt) L[(kt * 4 + vt) * 64 + lane] = (u32x2){pk2(S[kt][vt][0], S[kt][vt][1]), pk2(S[kt][vt][2], S[kt][vt][3])};
    ((float*)(a.ws + WS_SEGD))[unit * 64 + lane] = btot;
}
__device__ __forceinline__ void hgrn_pass2(const Args& a, int l, int unit, LAS unsigned char* wl, int lane) {
    const int j = unit % NSEGS, bh = unit / NSEGS, h = bh & 7, b = bh >> 3, fq = lane >> 4;
    f32x4 S[4][4]; zeroS(S); float btot = 0.f;
    {
        constexpr int PB = 3;
        const u32x2* Lb = (const u32x2*)(a.ws + WS_SEGL) + (size_t)bh * NSEGS * 1024 + lane; const float* Db = (const float*)(a.ws + WS_SEGD) + bh * NSEGS * 64 + 4 * fq;
        for (int i = 0; i < j; i += PB) {
            u32x2 lr[PB][16]; f32x4 dr[PB][4];
#pragma unroll
            for (int p = 0; p < PB; ++p) { const int ii = (i + p < j) ? i + p : j - 1;
#pragma unroll
                for (int q = 0; q < 16; ++q) lr[p][q] = Lb[(size_t)ii * 1024 + q * 64];
#pragma unroll
                for (int kt = 0; kt < 4; ++kt) dr[p][kt] = *(const f32x4*)(Db + ii * 64 + 16 * kt); }
#pragma unroll
            for (int p = 0; p < PB; ++p) if (i + p < j) {
#pragma unroll
                for (int kt = 0; kt < 4; ++kt)
#pragma unroll
                    for (int vt = 0; vt < 4; ++vt) { float t[4]; unpack4(lr[p][kt * 4 + vt], t); S[kt][vt] = S[kt][vt] * dr[p][kt] + (f32x4){t[0], t[1], t[2], t[3]}; } }
        }
    }
    hgrn_full<true>((const bf16*)(a.ws + WS_Z), (bf16*)(a.ws + WS_YMIX), b * SEQ + j * HSEG, HCH, h, hgrn_lb(a, l, h, lane), a.in[I_BGN] + l * 512 + h * 64, S, btot, wl, lane);
    if (j == NSEGS - 1) storeS_kv(S, a.out + O_HP + ((size_t)(l * NB + b) * 8 + h) * 4096, lane);
}
__device__ __forceinline__ void hgrn_sample(const Args& a, int l, int unit, LAS unsigned char* wl, int lane) {
    const int h = unit & 7, n = unit >> 3, fr = lane & 15, fq = lane >> 4;
    const float* s0 = a.in[I_SH] + ((size_t)(l * NS + n) * 8 + h) * 4096;
    f32x4 S[4][4]; float btot = 0.f;
#pragma unroll
    for (int kt = 0; kt < 4; ++kt)
#pragma unroll
        for (int vt = 0; vt < 4; ++vt)
#pragma unroll
            for (int j = 0; j < 4; ++j) S[kt][vt][j] = __builtin_nontemporal_load(s0 + (16 * kt + 4 * fq + j) * 64 + 16 * vt + fr);
    hgrn_run<true>((const bf16*)(a.ws + WS_Z), (bf16*)(a.ws + WS_YMIX), TP + 4 * n, 1, 4, h, hgrn_lb(a, l, h, lane), a.in[I_BGN] + l * 512 + h * 64, S, btot, wl, lane);
    storeS_kv(S, a.out + O_HS + ((size_t)(l * NS + n) * 8 + h) * 4096, lane);
}


template <int MODE, int K, int NTM = 8, int MT = 4> __device__ __forceinline__ void sgemm_phase(LAS unsigned char* lds, const bf16* A, const bf16* Bt, int N, bf16* O, int ldc, int tid, int wave, int lane, int bid, int G, const float* bias = nullptr, int rowlim = 0) {
    const int fr = lane & 15, fq = lane >> 4, ntiles = NTM * (N >> 6);
    constexpr int kw = K >> 3, NST = kw / 64;
    const bool xmap = (G & 7) == 0; const int nloc = xmap ? ntiles >> 3 : ntiles, jstep = xmap ? G >> 3 : G;
    for (int j = xmap ? bid >> 3 : bid; j < nloc; j += jstep) {
        const int tm = j & (NTM - 1), tn = xmap ? (bid & 7) + 8 * (j / NTM) : j / NTM;
        const bf16* Ap = A + (size_t)(tm * (16 * MT) + fr) * K + wave * kw + 16 * fq;
        const bf16* Bp = Bt + (size_t)(tn * 64 + fr) * K + wave * kw + 16 * fq;
        f32x4 acc[MT][4];
#pragma unroll
        for (int m = 0; m < MT; ++m)
#pragma unroll
            for (int n = 0; n < 4; ++n) acc[m][n] = (f32x4){0.f, 0.f, 0.f, 0.f};
        s16x8 a0[MT], a1[MT], b0[4], b1[4];
#pragma unroll
        for (int m = 0; m < MT; ++m) { a0[m] = *(const s16x8*)(Ap + (size_t)m * 16 * K); a1[m] = *(const s16x8*)(Ap + (size_t)m * 16 * K + 8); }
#pragma unroll
        for (int n = 0; n < 4; ++n) { b0[n] = *(const s16x8*)(Bp + (size_t)n * 16 * K); b1[n] = *(const s16x8*)(Bp + (size_t)n * 16 * K + 8); }
#pragma unroll
        for (int st = 0; st < NST; ++st) {
            s16x8 na0[MT], na1[MT], nb0[4], nb1[4];
            if (st + 1 < NST) {
                const int k = (st + 1) * 64;
#pragma unroll
                for (int m = 0; m < MT; ++m) { na0[m] = *(const s16x8*)(Ap + (size_t)m * 16 * K + k); na1[m] = *(const s16x8*)(Ap + (size_t)m * 16 * K + k + 8); }
#pragma unroll
                for (int n = 0; n < 4; ++n) { nb0[n] = *(const s16x8*)(Bp + (size_t)n * 16 * K + k); nb1[n] = *(const s16x8*)(Bp + (size_t)n * 16 * K + k + 8); }
            }
#pragma unroll
            for (int m = 0; m < MT; ++m)
#pragma unroll
                for (int n = 0; n < 4; ++n) { acc[m][n] = __builtin_amdgcn_mfma_f32_16x16x32_bf16(b0[n], a0[m], acc[m][n], 0, 0, 0); acc[m][n] = __builtin_amdgcn_mfma_f32_16x16x32_bf16(b1[n], a1[m], acc[m][n], 0, 0, 0); }
            if (st + 1 < NST) {
#pragma unroll
                for (int m = 0; m < MT; ++m) { a0[m] = na0[m]; a1[m] = na1[m]; }
#pragma unroll
                for (int n = 0; n < 4; ++n) { b0[n] = nb0[n]; b1[n] = nb1[n]; }
            }
        }
        LAS f32x4* red = (LAS f32x4*)lds + wave * 1024;
#pragma unroll
        for (int m = 0; m < MT; ++m)
#pragma unroll
            for (int n = 0; n < 4; ++n) red[(16 * m + fr) * 16 + ((4 * n + fq) ^ fr)] = acc[m][n];
        __syncthreads();
        const int row = tid >> 3, c4 = (tid & 7) * 2;
        if (tid < 128 * MT) {
        f32x4 s0 = {0.f, 0.f, 0.f, 0.f}, s1 = {0.f, 0.f, 0.f, 0.f};
#pragma unroll
        for (int w = 0; w < 8; ++w) { const LAS f32x4* r = (const LAS f32x4*)lds + w * 1024 + row * 16; s0 += r[c4 ^ (row & 15)]; s1 += r[(c4 + 1) ^ (row & 15)]; }
        if (MODE == 1) {
#pragma unroll
            for (int e = 0; e < 4; ++e) { const float x = s0[e] > 0.f ? s0[e] : 0.f; s0[e] = x * x; const float y = s1[e] > 0.f ? s1[e] : 0.f; s1[e] = y * y; } }
        if (MODE == 2) { const int col = tn * 64 + 4 * c4;
            if (tm * (16 * MT) + row < rowlim) { float* p = (float*)O + (size_t)(tm * (16 * MT) + row) * ldc + col; *(f32x4*)p = s0 + *(const f32x4*)(bias + col); *(f32x4*)(p + 4) = s1 + *(const f32x4*)(bias + col + 4); }
        } else {
        u32x4 w; w.x = pk2(s0[0], s0[1]); w.y = pk2(s0[2], s0[3]); w.z = pk2(s1[0], s1[1]); w.w = pk2(s1[2], s1[3]);
        *(u32x4*)(O + (size_t)(tm * (16 * MT) + row) * ldc + tn * 64 + 4 * c4) = w; }
        }
        __syncthreads();
    }
}


__device__ __forceinline__ void ada_phase(LAS unsigned char* lds, const Args& a, int tid, int wave, int lane, int bid, int G) {
    const int fr = lane & 15, fq = lane >> 4;
    constexpr int K = DM, kw = K / 8, NT = 3 * (2 * 6 * DM / 64);
    for (int tile = bid; tile < NT; tile += G) {
        const int tm = tile % 3, tn = tile / 3, l = tn / 96, nloc = (tn % 96) * 64;
        const float* W = a.in[I_WADA] + (size_t)l * DM * 6 * DM + (size_t)(wave * kw + 16 * fq) * (6 * DM) + nloc + fr;
        f32x4 acc[4][4];
#pragma unroll
        for (int m = 0; m < 4; ++m)
#pragma unroll
            for (int n = 0; n < 4; ++n) acc[m][n] = (f32x4){0.f, 0.f, 0.f, 0.f};
#pragma unroll
        for (int st = 0; st < kw / 64; ++st) {
            float bw[4][16];
#pragma unroll
            for (int n = 0; n < 4; ++n)
#pragma unroll
                for (int i = 0; i < 16; ++i) bw[n][i] = W[(size_t)(st * 64 + i) * (6 * DM) + 16 * n];
            s16x8 a0[4], a1[4];
#pragma unroll
            for (int m = 0; m < 4; ++m) { int row = tm * 64 + 16 * m + fr; row = row < NSEQ ? row : NSEQ - 1;
                const float* c = (row < NB ? a.in[I_CP] + (size_t)row * DM : a.in[I_CS] + (size_t)(row - NB) * DM) + wave * kw + st * 64 + 16 * fq;
                const f32x4 c0 = *(const f32x4*)c, c1 = *(const f32x4*)(c + 4), c2 = *(const f32x4*)(c + 8), c3 = *(const f32x4*)(c + 12);
                u32x4 p0, p1; p0.x = pk2(siluf_(c0[0]), siluf_(c0[1])); p0.y = pk2(siluf_(c0[2]), siluf_(c0[3])); p0.z = pk2(siluf_(c1[0]), siluf_(c1[1])); p0.w = pk2(siluf_(c1[2]), siluf_(c1[3]));
                p1.x = pk2(siluf_(c2[0]), siluf_(c2[1])); p1.y = pk2(siluf_(c2[2]), siluf_(c2[3])); p1.z = pk2(siluf_(c3[0]), siluf_(c3[1])); p1.w = pk2(siluf_(c3[2]), siluf_(c3[3]));
                a0[m] = __builtin_bit_cast(s16x8, p0); a1[m] = __builtin_bit_cast(s16x8, p1); }
#pragma unroll
            for (int n = 0; n < 4; ++n) {
                u32x4 q0, q1; q0.x = pk2(bw[n][0], bw[n][1]); q0.y = pk2(bw[n][2], bw[n][3]); q0.z = pk2(bw[n][4], bw[n][5]); q0.w = pk2(bw[n][6], bw[n][7]);
                q1.x = pk2(bw[n][8], bw[n][9]); q1.y = pk2(bw[n][10], bw[n][11]); q1.z = pk2(bw[n][12], bw[n][13]); q1.w = pk2(bw[n][14], bw[n][15]);
                const s16x8 b0 = __builtin_bit_cast(s16x8, q0), b1 = __builtin_bit_cast(s16x8, q1);
#pragma unroll
                for (int m = 0; m < 4; ++m) { acc[m][n] = __builtin_amdgcn_mfma_f32_16x16x32_bf16(b0, a0[m], acc[m][n], 0, 0, 0); acc[m][n] = __builtin_amdgcn_mfma_f32_16x16x32_bf16(b1, a1[m], acc[m][n], 0, 0, 0); } }
        }
        LAS f32x4* red = (LAS f32x4*)lds + wave * 1024;
#pragma unroll
        for (int m = 0; m < 4; ++m)
#pragma unroll
            for (int n = 0; n < 4; ++n) red[(16 * m + fr) * 16 + ((4 * n + fq) ^ fr)] = acc[m][n];
        __syncthreads();
        const int row = tid >> 3, c4 = (tid & 7) * 2;
        f32x4 s0 = {0.f, 0.f, 0.f, 0.f}, s1 = {0.f, 0.f, 0.f, 0.f};
#pragma unroll
        for (int w = 0; w < 8; ++w) { const LAS f32x4* r = (const LAS f32x4*)lds + w * 1024 + row * 16; s0 += r[c4 ^ (row & 15)]; s1 += r[(c4 + 1) ^ (row & 15)]; }
        const int col = tn * 64 + 4 * c4;
        if (tm * 64 + row < NSEQ) { float* p = (float*)(a.ws + WS_MOD) + (size_t)(tm * 64 + row) * MODLD + col; const float* bias = a.in[I_BADA] + col;
            *(f32x4*)p = s0 + *(const f32x4*)bias; *(f32x4*)(p + 4) = s1 + *(const f32x4*)(bias + 4); }
        __syncthreads();
    }
}

#define RLX_AGENT __ATOMIC_RELAXED, __HIP_MEMORY_SCOPE_AGENT
#define XB_TMO      128
#define XB_XCNT(j)  (256  + 64 * (j))
#define XB_XSUB(j)  (1280 + 64 * (j))
#define XB_XGEN(j)  (2304 + 64 * (j))
#define XB_TOP      3328
#define XB_TOPGEN   3392
#define XCD_BAR_WORDS 3456
#define XB_SPIN_CAP (1u << 18)

__device__ __forceinline__ unsigned xb_ld(unsigned* p)              { return __hip_atomic_load(p, __ATOMIC_RELAXED, __HIP_MEMORY_SCOPE_AGENT); }
__device__ __forceinline__ unsigned xb_add(unsigned* p, unsigned v) { return __hip_atomic_fetch_add(p, v, __ATOMIC_RELAXED, __HIP_MEMORY_SCOPE_AGENT); }
__device__ __forceinline__ unsigned xb_xcc_id() { return (unsigned)__builtin_amdgcn_s_getreg((3 << 11) | 20) & 0xFu; }
#define XB_SPIN(cond, bar) do { unsigned _sp = 0; while (cond) { __builtin_amdgcn_s_sleep(1); \
    if ((++_sp & 255u) == 0u) { if (xb_ld(&(bar)[XB_TMO])) break; if (_sp > XB_SPIN_CAP) { atomicAdd(&(bar)[XB_TMO], 1u); break; } } } } while (0)

struct XcdBarrier {
    unsigned* bar; unsigned x;
    volatile LAS unsigned* st;
};

__device__ __forceinline__ XcdBarrier xcd_barrier_post(unsigned* bar, volatile LAS unsigned* st) {
    XcdBarrier b; b.bar = bar; b.x = xb_xcc_id(); b.st = st;
    if (threadIdx.x == 0) (void)xb_add(&bar[XB_XCNT(b.x)], 1u);
    return b;
}
__device__ __forceinline__ void xcd_barrier_complete(unsigned* bar, unsigned x, unsigned& nloc, unsigned& nx) {
    const unsigned G = gridDim.x * gridDim.y * gridDim.z;
    unsigned sum, cnt, mine, sp = 0u;
    for (;;) {
        sum = 0u; cnt = 0u; mine = 0u;
#pragma unroll
        for (unsigned j = 0; j < 16; ++j) { const unsigned c = xb_ld(&bar[XB_XCNT(j)]); sum += c; cnt += (c > 0u) ? 1u : 0u; mine = (j == x) ? c : mine; }
        if (sum == G) break;
        __builtin_amdgcn_s_sleep(1);
        if ((++sp & 255u) == 0u) { if (xb_ld(&bar[XB_TMO])) break; if (sp > XB_SPIN_CAP) { atomicAdd(&bar[XB_TMO], 1u); break; } }
    }
    nloc = mine > 0u ? mine : 1u; nx = cnt > 0u ? cnt : 1u;
}

__device__ __forceinline__ void xcd_barrier(const XcdBarrier& b) {
    asm volatile("s_waitcnt vmcnt(0)" ::: "memory");
    __syncthreads();
    if (threadIdx.x == 0) {
        unsigned* bar = b.bar;
        __builtin_amdgcn_s_waitcnt(0);
        unsigned nloc = b.st[0], nx = b.st[1];
        if (nloc == 0u) { xcd_barrier_complete(bar, b.x, nloc, nx); b.st[0] = nloc; b.st[1] = nx; }
        const unsigned old = xb_add(&bar[XB_XSUB(b.x)], 1u);
        const unsigned gen = old / nloc;
        if (old + 1u == (gen + 1u) * nloc) {
            __builtin_amdgcn_fence(__ATOMIC_RELEASE, "agent");
            asm volatile("s_waitcnt vmcnt(0)" ::: "memory");
            const unsigned og = xb_add(&bar[XB_TOP], 1u);
            const unsigned tg = og / nx;
            if (og + 1u == (tg + 1u) * nx) xb_add(&bar[XB_TOPGEN], 1u);
            else XB_SPIN(xb_ld(&bar[XB_TOPGEN]) == tg, bar);
            __builtin_amdgcn_fence(__ATOMIC_ACQUIRE, "agent");
            xb_add(&bar[XB_XGEN(b.x)], 1u);
            asm volatile("s_waitcnt vmcnt(0)" ::: "memory");
        } else {
            XB_SPIN(xb_ld(&bar[XB_XGEN(b.x)]) == gen, bar);
            __builtin_amdgcn_fence(__ATOMIC_ACQUIRE, "agent");
            asm volatile("s_waitcnt vmcnt(0)" ::: "memory");
        }
    }
    __syncthreads();
}

constexpr int CW_BAR = 4096, LDS_MISC_OFF = 131072 + 64;
#define GSYNC() xcd_barrier(xbar)

__device__ __forceinline__ Args load_args() {
#if defined(__HIP_DEVICE_COMPILE__)
    const __attribute__((address_space(4))) void* p = (const __attribute__((address_space(4))) void*)__builtin_amdgcn_kernarg_segment_ptr(); asm volatile("" : "+s"(p));
    const __attribute__((address_space(4))) Args* q = (const __attribute__((address_space(4))) Args*)p;
    Args r;
#pragma unroll
    for (int i = 0; i < 26; ++i) r.in[i] = q->in[i];
    r.out = q->out; r.ws = q->ws; return r;
#else
    return Args{};
#endif
}
#define PH_IDS() int tid = threadIdx.x; asm volatile("" : "+v"(tid)); const int lane = tid & 63, wave = __builtin_amdgcn_readfirstlane(tid >> 6); \
    const int G = gridDim.x, bid = blockIdx.x, gw = bid * NWAVES + wave, NGW = G * NWAVES; const Args a = load_args(); unsigned char* ws = a.ws; \
    (void)lane; (void)wave; (void)gw; (void)NGW; (void)ws; (void)G; (void)bid;
template <int MODE> __device__ __forceinline__ void run_gemm(LAS unsigned char* lds, const void* A, const void* Bt, int M, int N, int K, void* O, int ldc, const float* bias, int rowlim) {
    pg8::Gemm g{(const pg8::bf16_t*)A, (const pg8::bf16_t*)Bt, M, N, K}; pg8::StaticOrder S; S.init(M, N, (int)gridDim.x, (int)blockIdx.x);
    pg8::EpiT<MODE> E{O, ldc, bias, rowlim};
    pg8::gemm_phase<pg8::EpiT<MODE>, pg8::StaticOrder, true, true>(lds, g, S, E);
}
template <int L> __device__ __forceinline__ void layer_body(LAS unsigned char* lds, const XcdBarrier& xbar) {
    constexpr int l = L;
    { PH_IDS(); run_gemm<0>(lds, ws + WS_HY, (const bf16*)(ws + WS_WIN) + (size_t)l * NIN * DM, TP, NIN, DM, ws + WS_Z, NIN, nullptr, 0); }
    { PH_IDS(); sgemm_phase<0, DM>(lds, (const bf16*)(ws + WS_HY) + (size_t)TP * DM, (const bf16*)(ws + WS_WIN) + (size_t)l * NIN * DM, NIN, (bf16*)(ws + WS_Z) + (size_t)TP * NIN, NIN, tid, wave, lane, bid, G); }
    GSYNC();
    {
        PH_IDS();
        constexpr int N_CONVP = NB * (SEQ / 64), N_CONVS = NS;
#ifndef NO_CONV
        for (int it = bid; it < N_CONVP + N_CONVS; it += G) {
            if (it < N_CONVP) conv_item(a, l, it / (SEQ / 64), (it % (SEQ / 64)) * 64, 64, lds, tid, wave, lane);
            else conv_item(a, l, NB + (it - N_CONVP), 0, 4, lds, tid, wave, lane);
        }
#endif
    }
    {   PH_IDS();
#ifndef NO_GMLP
        for (int it = G - 1 - bid; it < 2 * (TP / 128); it += G) { if (it & 1) gmlp_chunk<1>(a, l, it >> 1, lds, wave, lane); else gmlp_chunk<0>(a, l, it >> 1, lds, wave, lane); }
#endif
    }
    {   PH_IDS();
        LAS unsigned char* wl = lds + wave * 8192;
#ifndef NO_HGRN
        if (wave < 4) { for (int it = wave * G + bid; it < NB * 8 * NSEGS; it += 4 * G) hgrn_pass1(a, l, it, wl, lane); }
        else { for (int it = (wave - 4) * G + bid; it < NS * 8; it += 4 * G) hgrn_sample(a, l, it, wl, lane);
               if (l == 0) for (int it = (wave - 4) * G + bid; it < N_LATE0; it += 4 * G) late_item(a, 0, it, lane); }
#endif
    }
    {   PH_IDS();
#ifndef NO_GMLP
        for (int it = NGW - 1 - gw; it < NS; it += NGW) gmlp_sample(a, l, it, lane);
#endif
    }
    GSYNC();
    {
        PH_IDS();
        LAS unsigned char* wl = lds + wave * 8192;
#ifndef NO_HGRN
        for (int it = wave * G + bid; it < NB * 8 * NSEGS; it += NWAVES * G) hgrn_pass2(a, l, it, wl, lane);
        if (l == 0 && wave >= 4) for (int it = (wave - 4) * G + bid; it < N_LATE1; it += 4 * G) late_item(a, 1, it, lane);
#endif
    }
    GSYNC();
    { PH_IDS(); run_gemm<0>(lds, ws + WS_YMIX, (const bf16*)(ws + WS_WOUT) + (size_t)l * DM * DM, TP, DM, DM, ws + WS_HY, DM, nullptr, 0); }
    { PH_IDS(); sgemm_phase<0, DM, 16, 2>(lds, (const bf16*)(ws + WS_YMIX) + (size_t)TP * DM, (const bf16*)(ws + WS_WOUT) + (size_t)l * DM * DM, DM, (bf16*)(ws + WS_HY) + (size_t)TP * DM, DM, tid, wave, lane, G - 1 - bid, G); }
    GSYNC();
    { PH_IDS(); postnorm_phase<L, 0>(a, gw, NGW, lane); }
#ifndef SKIP_MLP
    GSYNC();
    { PH_IDS(); run_gemm<1>(lds, ws + WS_HY, (const bf16*)(ws + WS_WUP) + (size_t)l * DFF * DM, TP, DFF, DM, ws + WS_U, DFF, nullptr, 0); }
    { PH_IDS(); sgemm_phase<1, DM>(lds, (const bf16*)(ws + WS_HY) + (size_t)TP * DM, (const bf16*)(ws + WS_WUP) + (size_t)l * DFF * DM, DFF, (bf16*)(ws + WS_U) + (size_t)TP * DFF, DFF, tid, wave, lane, bid, G); }
    GSYNC();
    { PH_IDS(); run_gemm<0>(lds, ws + WS_U, (const bf16*)(ws + WS_WDN) + (size_t)l * DM * DFF, TP, DM, DFF, ws + WS_HY, DM, nullptr, 0); }
    { PH_IDS(); sgemm_phase<0, DFF, 16, 2>(lds, (const bf16*)(ws + WS_U) + (size_t)TP * DFF, (const bf16*)(ws + WS_WDN) + (size_t)l * DM * DFF, DM, (bf16*)(ws + WS_HY) + (size_t)TP * DM, DM, tid, wave, lane, G - 1 - bid, G); }
    GSYNC();
    { PH_IDS(); postnorm_phase<L, 1>(a, gw, NGW, lane); }
#endif
}
__global__ void __launch_bounds__(NWAVES * 64, 2) fwd_kernel(Args a_unused) {
    extern __shared__ __attribute__((aligned(16))) unsigned char lds_raw[];
    LAS unsigned char* lds = (LAS unsigned char*)lds_raw;
    cg::grid_group grid = cg::this_grid();
    XcdBarrier xbar;
    {   PH_IDS();
        if (tid < 16) ((LAS unsigned*)(lds + LDS_MISC_OFF))[tid] = 0u;
        __syncthreads();
        xbar = xcd_barrier_post((unsigned*)ws + CW_BAR, (volatile LAS unsigned*)(lds + LDS_MISC_OFF));
    }
    asm volatile("s_waitcnt vmcnt(0)" ::: "memory");
    grid.sync();
    { PH_IDS(); p0_prologue(a, lds, NGW - 1 - gw, NGW, wave, lane); }
    { PH_IDS(); ada_phase(lds, a, tid, wave, lane, bid, G); }
    GSYNC();
    { PH_IDS(); prenorm0_phase(a, gw, NGW, lane); }
    GSYNC();
    layer_body<0>(lds, xbar);
#ifndef ONLY_L0
    GSYNC();
    layer_body<1>(lds, xbar);
#endif
}

extern "C" void kernel_launch(void* const* d_in, const int* in_sizes, int n_in, void* d_out, int out_size, void* d_ws, size_t ws_size, hipStream_t stream) {
    static int grid = 0;
    if (grid == 0) {
        if (n_in != 26 || ws_size < WS_END) { fprintf(stderr, "kernel_launch: unexpected n_in %d / ws_size %zu\n", n_in, ws_size); grid = -1; return; }
        int dev = 0, cus = 0, per_cu = 0;
        (void)hipGetDevice(&dev); (void)hipDeviceGetAttribute(&cus, hipDeviceAttributeMultiprocessorCount, dev);
        (void)hipFuncSetAttribute((const void*)fwd_kernel, hipFuncAttributeMaxDynamicSharedMemorySize, LDS_BYTES);
        (void)hipOccupancyMaxActiveBlocksPerMultiprocessor(&per_cu, (const void*)fwd_kernel, NWAVES * 64, LDS_BYTES);
        if (per_cu < 1) { fprintf(stderr, "kernel_launch: occupancy query says %d blocks/CU\n", per_cu); per_cu = 1; }
        grid = cus;
        fprintf(stderr, "kernel_launch: grid %d (cus %d, per_cu %d), ws %zu\n", grid, cus, per_cu, ws_size);
    }
    if (grid < 0) return;
    (void)hipMemsetAsync(d_ws, 0, 65536, stream);
    Args a{};
    for (int i = 0; i < 26; ++i) a.in[i] = (const float*)d_in[i];
    a.out = (float*)d_out; a.ws = (unsigned char*)d_ws;
    void* args[] = {&a};
    hipError_t e = hipLaunchCooperativeKernel((const void*)fwd_kernel, dim3(grid), dim3(NWAVES * 64), args, LDS_BYTES, stream);
    if (e != hipSuccess) fprintf(stderr, "kernel_launch: cooperative launch failed: %s\n", hipGetErrorString(e));
}
```
